# Optimizing an MI355X kernel written in HIP

```python
import jax, jax.numpy as jnp
from jax import lax
import numpy as np

D_MODEL = 1024
BATCH = 2
SEQ = 8192
DEPTH = 1

GRID_W = 64
CTX_LEN = 256
N_MOD = 6
POOL_WINDOWS = (2, 4, 8, 16)
N_POOL_GROUPS = 4
POOL_GROUP_DIM = D_MODEL // 8
POOL_WIDTH = N_POOL_GROUPS * POOL_GROUP_DIM
HEAD_DIM = 64
NA_HEADS = (D_MODEL // 2) // HEAD_DIM
NA_WIDTH = NA_HEADS * HEAD_DIM
NA_ROWS = 8
NA_COLS = 16
D_FF = 4 * D_MODEL
ROPE_THETA = 10000.0
EPS = 1e-6
IN_WIDTH = POOL_WIDTH + 3 * NA_WIDTH + 2 * D_MODEL
SPLIT_POINTS = (POOL_WIDTH, POOL_WIDTH + NA_WIDTH, POOL_WIDTH + 2 * NA_WIDTH,
                POOL_WIDTH + 3 * NA_WIDTH, POOL_WIDTH + 3 * NA_WIDTH + D_MODEL)
KV_START = POOL_WIDTH + NA_WIDTH
KV_END = POOL_WIDTH + 3 * NA_WIDTH

kernel_name = "hybrid_pool_natten_dit_block"


def rmsnorm(x, g):
    xf = x.astype(jnp.float32)
    y = xf * lax.rsqrt(jnp.mean(xf * xf, axis=-1, keepdims=True) + EPS)
    return (y * g.astype(jnp.float32)).astype(x.dtype)


def heads(a):
    return a.reshape(a.shape[0], a.shape[1], NA_HEADS, HEAD_DIM)


def axial_rope(a, ang_row, ang_col):
    n = HEAD_DIM // 4

    def rot(xh, ang):
        cs = jnp.cos(ang)[None, :, None, :]
        sn = jnp.sin(ang)[None, :, None, :]
        x1, x2 = xh[..., :n], xh[..., n:]
        return jnp.concatenate([x1 * cs - x2 * sn, x1 * sn + x2 * cs], axis=-1)

    af = a.astype(jnp.float32)
    out = jnp.concatenate([rot(af[..., :2 * n], ang_row), rot(af[..., 2 * n:], ang_col)], axis=-1)
    return out.astype(a.dtype)


def pool_mixer(u, pool_w, pool_scale):
    L = u.shape[1]
    uf = u.astype(jnp.float32)
    cs = jnp.concatenate([jnp.zeros_like(uf[:, :1]), jnp.cumsum(uf, axis=1)], axis=1)
    t = jnp.arange(L)
    outs = []
    for g, w in enumerate(POOL_WINDOWS):
        lo = jnp.clip(t - w // 2, 0, L)
        hi = jnp.clip(t + w // 2, 0, L)
        csg = cs[..., g * POOL_GROUP_DIM:(g + 1) * POOL_GROUP_DIM]
        mean = (csg[:, hi] - csg[:, lo]) / (hi - lo).astype(jnp.float32)[:, None]
        outs.append(mean - uf[..., g * POOL_GROUP_DIM:(g + 1) * POOL_GROUP_DIM])
    d = jnp.stack(outs, axis=2).astype(u.dtype)
    y = jnp.einsum('blgc,gce->blge', d, pool_w)
    return y.reshape(u.shape) * pool_scale


def neighbourhood_attention(q_rot, q_plain, k_rot, v, k_ctx, v_ctx, rpb):
    B, L = q_rot.shape[0], q_rot.shape[1]
    rows = L // GRID_W
    kr = min(NA_ROWS, rows)
    kc = NA_COLS
    scale = HEAD_DIM ** -0.5

    def grid(a):
        return a.reshape(B, rows, GRID_W, NA_HEADS, HEAD_DIM)

    qg, qpg, kg, vg = grid(q_rot), grid(q_plain), grid(k_rot), grid(v)
    col = jnp.arange(GRID_W)
    c0 = jnp.clip(col - kc // 2, 0, GRID_W - kc)
    col_idx = c0[:, None] + jnp.arange(kc)[None, :]
    col_rel = col_idx - col[:, None] + (NA_COLS - 1)

    def row_block(r):
        r0 = jnp.clip(r - kr // 2, 0, rows - kr)
        q_r = lax.dynamic_index_in_dim(qg, r, axis=1, keepdims=False)
        qp_r = lax.dynamic_index_in_dim(qpg, r, axis=1, keepdims=False)
        k_rows = lax.dynamic_slice_in_dim(kg, r0, kr, axis=1)
        v_rows = lax.dynamic_slice_in_dim(vg, r0, kr, axis=1)
        k_win = k_rows[:, :, col_idx]
        v_win = v_rows[:, :, col_idx]
        row_rel = r0 + jnp.arange(kr) - r + (NA_ROWS - 1)
        bias = rpb[:, row_rel][:, :, col_rel].transpose(0, 2, 1, 3)
        s_loc = jnp.einsum('bchd,brckhd->bhcrk', q_r, k_win).astype(jnp.float32) * scale
        s_loc = s_loc + bias.astype(jnp.float32)[None]
        s_ctx = jnp.einsum('bchd,bnhd->bhcn', qp_r, k_ctx).astype(jnp.float32) * scale
        s = jnp.concatenate([s_loc.reshape(B, NA_HEADS, GRID_W, kr * kc), s_ctx], axis=-1)
        p = jax.nn.softmax(s, axis=-1).astype(v.dtype)
        p_loc = p[..., :kr * kc].reshape(B, NA_HEADS, GRID_W, kr, kc)
        p_ctx = p[..., kr * kc:]
        return (jnp.einsum('bhcrk,brckhd->bchd', p_loc, v_win)
                + jnp.einsum('bhcn,bnhd->bchd', p_ctx, v_ctx))

    o = lax.map(row_block, jnp.arange(rows))
    return o.transpose(1, 0, 2, 3, 4).reshape(B, L, NA_WIDTH)


def context_attention(q, k, v):
    s = jnp.einsum('bqhd,bkhd->bhqk', q, k).astype(jnp.float32) * (HEAD_DIM ** -0.5)
    p = jax.nn.softmax(s, axis=-1).astype(v.dtype)
    o = jnp.einsum('bhqk,bkhd->bqhd', p, v)
    return o.reshape(o.shape[0], o.shape[1], NA_WIDTH)


def sq_relu_mlp(h, w1, w2):
    a = jax.nn.relu(h @ w1)
    return (a * a) @ w2


def setup_inputs(seed: int = 0) -> dict:
    key = jax.random.key(seed)
    ks = jax.random.split(key, 19)
    f32 = jnp.float32
    nrm = lambda k, shape, s: jax.random.normal(k, shape, f32) * s
    return {
        "x": nrm(ks[0], (BATCH, SEQ, D_MODEL), 1.0),
        "c": nrm(ks[1], (BATCH, D_MODEL), 1.0),
        "ctx": nrm(ks[2], (BATCH, CTX_LEN, D_MODEL), 1.0),
        "c_ctx": nrm(ks[3], (D_MODEL,), 1.0),
        "ada_w": nrm(ks[4], (DEPTH, D_MODEL, N_MOD * D_MODEL), D_MODEL ** -0.5),
        "ada_b": nrm(ks[5], (DEPTH, N_MOD * D_MODEL), 0.02),
        "norm1_g": 1.0 + nrm(ks[6], (DEPTH, D_MODEL), 0.05),
        "norm2_g": 1.0 + nrm(ks[7], (DEPTH, D_MODEL), 0.05),
        "w_in": nrm(ks[8], (DEPTH, D_MODEL, IN_WIDTH), D_MODEL ** -0.5),
        "pool_w": nrm(ks[9], (DEPTH, N_POOL_GROUPS, POOL_GROUP_DIM, POOL_GROUP_DIM), POOL_GROUP_DIM ** -0.5),
        "pool_scale": 1.0 + nrm(ks[10], (DEPTH, POOL_WIDTH), 0.1),
        "q_norm_g": 1.0 + nrm(ks[11], (DEPTH, HEAD_DIM), 0.05),
        "k_norm_g": 1.0 + nrm(ks[12], (DEPTH, HEAD_DIM), 0.05),
        "rpb": nrm(ks[13], (DEPTH, NA_HEADS, 2 * NA_ROWS - 1, 2 * NA_COLS - 1), 0.2),
        "w_branch_pool": nrm(ks[14], (DEPTH, POOL_WIDTH, D_MODEL), POOL_WIDTH ** -0.5),
        "w_branch_na": nrm(ks[15], (DEPTH, NA_WIDTH, D_MODEL), NA_WIDTH ** -0.5),
        "w_out": nrm(ks[16], (DEPTH, D_MODEL, D_MODEL), D_MODEL ** -0.5),
        "mlp_w1": nrm(ks[17], (DEPTH, D_MODEL, D_FF), D_MODEL ** -0.5),
        "mlp_w2": nrm(ks[18], (DEPTH, D_FF, D_MODEL), D_FF ** -0.5),
    }


def reference(x, c, ctx, c_ctx, ada_w, ada_b, norm1_g, norm2_g, w_in, pool_w, pool_scale,
              q_norm_g, k_norm_g, rpb, w_branch_pool, w_branch_na, w_out, mlp_w1, mlp_w2):
    L = x.shape[1]
    t = jnp.arange(L)
    n_freq = HEAD_DIM // 4
    inv = ROPE_THETA ** (-jnp.arange(n_freq, dtype=jnp.float32) / n_freq)
    ang_row = (t // GRID_W).astype(jnp.float32)[:, None] * inv
    ang_col = (t % GRID_W).astype(jnp.float32)[:, None] * inv
    silu_c = jax.nn.silu(c)
    silu_cc = jax.nn.silu(c_ctx)

    for l in range(DEPTH):
        last = l == DEPTH - 1
        mod = (silu_c @ ada_w[l] + ada_b[l])[:, None, :]
        sh1, s1, g1, sh2, s2, g2 = jnp.split(mod, N_MOD, axis=-1)
        mod_c = silu_cc @ ada_w[l] + ada_b[l]
        csh1, cs1, cg1, csh2, cs2, cg2 = jnp.split(mod_c, N_MOD, axis=-1)

        h = rmsnorm(x, norm1_g[l]) * (1.0 + s1) + sh1
        hc = rmsnorm(ctx, norm1_g[l]) * (1.0 + cs1) + csh1
        z = h @ w_in[l]
        u_pool, q, k, v, gate_pool, gate_na = jnp.split(z, SPLIT_POINTS, axis=-1)
        if last:
            zc_kv = hc @ w_in[l][:, KV_START:KV_END]
            kc_, vc_ = jnp.split(zc_kv, 2, axis=-1)
        else:
            zc = hc @ w_in[l]
            uc_pool, qc_, kc_, vc_, gc_pool, gc_na = jnp.split(zc, SPLIT_POINTS, axis=-1)
        k_ctx = rmsnorm(heads(kc_), k_norm_g[l])
        v_ctx = heads(vc_)

        q = rmsnorm(heads(q), q_norm_g[l])
        k = rmsnorm(heads(k), k_norm_g[l])
        q_rot = axial_rope(q, ang_row, ang_col)
        k_rot = axial_rope(k, ang_row, ang_col)
        na = neighbourhood_attention(q_rot, q, k_rot, heads(v), k_ctx, v_ctx, rpb[l])
        pool = pool_mixer(u_pool, pool_w[l], pool_scale[l])
        merged = (jax.nn.sigmoid(gate_pool) * (pool @ w_branch_pool[l])
                  + jax.nn.sigmoid(gate_na) * (na @ w_branch_na[l]))
        x_new = x + g1 * (merged @ w_out[l])
        h2 = rmsnorm(x_new, norm2_g[l]) * (1.0 + s2) + sh2
        x_new = x_new + g2 * sq_relu_mlp(h2, mlp_w1[l], mlp_w2[l])

        if not last:
            qc = rmsnorm(heads(qc_), q_norm_g[l])
            na_c = context_attention(qc, k_ctx, v_ctx)
            pool_c = pool_mixer(uc_pool, pool_w[l], pool_scale[l])
            merged_c = (jax.nn.sigmoid(gc_pool) * (pool_c @ w_branch_pool[l])
                        + jax.nn.sigmoid(gc_na) * (na_c @ w_branch_na[l]))
            ctx = ctx + cg1 * (merged_c @ w_out[l])
            h2c = rmsnorm(ctx, norm2_g[l]) * (1.0 + cs2) + csh2
            ctx = ctx + cg2 * sq_relu_mlp(h2c, mlp_w1[l], mlp_w2[l])
        x = x_new
    return x
```

```cpp
#include <hip/hip_runtime.h>
#include <cstdio>
#include <cstdint>

#ifndef ONE_LAUNCH
#define ONE_LAUNCH 1
#endif
#ifndef DUP_PHASE
#define DUP_PHASE -1
#endif
#ifndef DUP_MODE
#define DUP_MODE 1
#endif
#ifndef DUP_VARIANT
#define DUP_VARIANT 0
#endif
#ifndef NAIVE_MASK
#define NAIVE_MASK 0x00
#endif

#define GAS __attribute__((address_space(1)))
#define LAS __attribute__((address_space(3)))
typedef unsigned short bf16_t;
typedef short bf16x8 __attribute__((ext_vector_type(8)));
typedef float f32x2 __attribute__((ext_vector_type(2)));
typedef float f32x4 __attribute__((ext_vector_type(4)));
typedef float f32x16 __attribute__((ext_vector_type(16)));
typedef unsigned u32x2 __attribute__((ext_vector_type(2)));
typedef unsigned u32x4 __attribute__((ext_vector_type(4)));
typedef __bf16 bf16x2_t __attribute__((ext_vector_type(2)));

constexpr int NB = 2, SEQ = 8192, DM = 1024, MTOK = NB * SEQ, CTXL = 256, MCTX = NB * CTXL, FF = 4096, INW = 4096;
constexpr int NH = 8, HD = 64, NAW = 512, PW = 512, GW = 64, NROWS = SEQ / GW;
constexpr float EPS = 1e-6f;
constexpr int NPH = 8;

constexpr size_t MiB = 1u << 20;
constexpr size_t WS_CTL = 0, CTL_ZERO_BYTES = 128 * 1024;
constexpr size_t WS_SMALL = 1 * MiB;
constexpr size_t OFF_MODP = 0;
constexpr size_t OFF_MOD = 294912;
constexpr size_t OFF_TAB = OFF_MOD + 73728;
constexpr size_t OFF_BIAS2 = OFF_TAB + 16384;
constexpr size_t OFF_ROWP = OFF_BIAS2 + 32768;
static_assert(OFF_ROWP + 262144 <= MiB, "small region");
constexpr size_t WS_WTIN = 2 * MiB, WS_WTBR = 11 * MiB, WS_WTOUT = 13 * MiB, WS_WT1 = 15 * MiB, WS_WT2 = 23 * MiB;
constexpr size_t WS_KC = 31 * MiB, WS_VCT = 31 * MiB + 512 * 1024;
constexpr size_t WS_ROWP = 32 * MiB;
constexpr size_t WS_XN = 34 * MiB;
constexpr size_t WS_U = 67 * MiB, WS_QR = 83 * MiB, WS_QP = 99 * MiB, WS_KR = 115 * MiB, WS_VT = 131 * MiB, WS_SGP = 147 * MiB, WS_SGN = 179 * MiB, WS_DN = 211 * MiB;
constexpr size_t WS_ZC = 243 * MiB;
constexpr size_t WS_MG = 34 * MiB, WS_TMP = 67 * MiB, WS_XG = 67 * MiB, WS_H = 128 * MiB, WS_END = 256 * MiB;

__device__ __forceinline__ unsigned pk2(float lo, float hi) { f32x2 v = {lo, hi}; bf16x2_t b = __builtin_convertvector(v, bf16x2_t); return __builtin_bit_cast(unsigned, b); }
__device__ __forceinline__ bf16_t f2bf(float f) { return (bf16_t)(pk2(f, 0.f) & 0xffffu); }
__device__ __forceinline__ float bf2f(bf16_t h) { return __uint_as_float(((unsigned)h) << 16); }
__device__ __forceinline__ float bflo(unsigned w) { return __uint_as_float(w << 16); }
__device__ __forceinline__ float bfhi(unsigned w) { return __uint_as_float(w & 0xffff0000u); }
__device__ __forceinline__ float sigmoidf_(float x) { return __builtin_amdgcn_rcpf(1.0f + __expf(-x)); }
__device__ __forceinline__ float siluf_(float x) { return x / (1.0f + __expf(-x)); }
__device__ __forceinline__ float wave_sum(float v) {
#pragma unroll
    for (int o = 1; o < 64; o <<= 1) v += __shfl_xor(v, o);
    return v;
}
#define LDS_WAIT() asm volatile("s_waitcnt lgkmcnt(0)" ::: "memory")
#define VM_WAIT() asm volatile("s_waitcnt vmcnt(0)" ::: "memory")

__host__ __device__ __forceinline__ int inv_std(int a) { return (a & 0xE3) | ((a & 0x04) << 2) | ((a & 0x18) >> 1); }
__host__ __device__ __forceinline__ int inv_head(int a) { const int wc = a >> 6, fh = (a >> 5) & 1, bj = (a >> 4) & 1, fl = (a >> 3) & 1, n = (a >> 2) & 1, j = a & 3; return (bj << 7) | (wc << 5) | (n << 4) | (fh << 3) | (fl << 2) | j; }
__host__ __device__ __forceinline__ int fwd_std(int p) { return (p & 0xE3) | ((p & 0x0C) << 1) | ((p & 0x10) >> 2); }
__host__ __device__ __forceinline__ int wrow_std(int n) { return (n & ~255) | inv_std(n & 255); }
__host__ __device__ __forceinline__ int wrow_in(int n) { const int t = n >> 8, a = n & 255; const int p = (t >= 2 && t <= 5) ? inv_head(a) : ((t == 6 || t == 7) ? a : inv_std(a)); return (t << 8) | p; }

namespace pg8 {
constexpr int BM = 256, BK = 64, HALF = 128, HTB = HALF * BK * 2, STAGE_BYTES = 8 * HTB, NXCD = 8, WGM = 8;
__host__ __device__ __forceinline__ int lds_byte(int r, int c) { const int st = (r >> 4) * 2 + (c >> 5), rr = r & 15, cc = c & 31, ob = rr * 64 + cc * 2; return st * 1024 + (ob ^ (((ob >> 9) & 1) << 5)); }
__host__ __device__ __forceinline__ void stage_rc(int b, int& R, int& C) { const int st = b / 1024, sb = b % 1024, swz = sb ^ (((sb >> 9) & 1) << 5); R = (st >> 1) * 16 + swz / 64; C = (st & 1) * 32 + (swz % 64) / 2; }

struct Unit { int pm, pn, kind; };
struct Gemm { int ld, K; };

__device__ __forceinline__ bool static_tile(int nM, int nN, int G, int c, int i, int& pm, int& pn) {
    const int nwg = nM * nN; const long L = (long)i * G + c; if (L >= nwg) return false;
    int wgid = (int)L; { const int q = nwg / NXCD, r = nwg % NXCD, xcd = wgid % NXCD, off = wgid / NXCD; wgid = (xcd < r ? xcd * (q + 1) : r * (q + 1) + (xcd - r) * q) + off; }
    const int nig = WGM * nN, gid = wgid / nig, fm = gid * WGM, gsz = (nM - fm) < WGM ? (nM - fm) : WGM;
    pm = fm + ((wgid % nig) % gsz); pn = (wgid % nig) / gsz; return true;
}

template <class Epi, class Sched, bool ALIGN_EPI, bool SP2, bool ATILED = false>
__device__ __forceinline__ void gemm_phase(LAS unsigned char* lds, const Gemm g, const Sched& S, const Epi& E) {
    const int tid = threadIdx.x, wid = __builtin_amdgcn_readfirstlane(tid >> 6), lane = tid & 63, wr = wid >> 2, wc = wid & 3, fr = lane & 15, fq = lane >> 4;
    const int K = g.K, nt = K / BK, ld = g.ld;
    unsigned voffA[2], voffB[2];
#pragma unroll
    for (int i = 0; i < 2; ++i) { int R, C; stage_rc(tid * 16 + i * 8192, R, C); voffB[i] = (unsigned)(R * ld + C) * 2u; voffA[i] = ATILED ? (unsigned)(R * BK + C) * 2u : voffB[i]; }
    const size_t kstepB = (size_t)(BK * 2), kstepA = ATILED ? (size_t)(BM * BK * 2) : kstepB;
    const size_t hstepB = (size_t)HALF * ld * 2, hstepA = ATILED ? (size_t)(HALF * BK * 2) : hstepB;
    const unsigned ldsw = (unsigned)wid * 1024u;
    const int aoff = lds_byte(wr * 64 + fr, fq * 8), boff = lds_byte(wc * 32 + fr, fq * 8);
#define PG8_SA(b, h) (((b) * 2 + (h)) * HTB)
#define PG8_SB(b, h) ((4 + (b) * 2 + (h)) * HTB)
#define PG8_STAGEX(bufoff, gbase, vo) do { _Pragma("unroll") for (int _i = 0; _i < 2; ++_i) \
        __builtin_amdgcn_global_load_lds((const unsigned*)((const char*)(gbase) + vo[_i]), (LAS unsigned*)(lds + (bufoff) + ldsw + _i * 8192), 16, 0, 0); } while (0)
#define PG8_STAGEA(bufoff, gbase) PG8_STAGEX(bufoff, gbase, voffA)
#define PG8_STAGEB(bufoff, gbase) PG8_STAGEX(bufoff, gbase, voffB)
#define PG8_LDA(dst, b, h) do { _Pragma("unroll") for (int m = 0; m < 4; ++m) _Pragma("unroll") for (int k = 0; k < 2; ++k) dst[m][k] = *(const LAS bf16x8*)(lds + PG8_SA(b, h) + aoff + m * 2048 + k * 1024); } while (0)
#define PG8_LDB(dst, b, h) do { _Pragma("unroll") for (int n = 0; n < 2; ++n) _Pragma("unroll") for (int k = 0; k < 2; ++k) dst[n][k] = *(const LAS bf16x8*)(lds + PG8_SB(b, h) + boff + n * 2048 + k * 1024); } while (0)
#define PG8_MMA(ai, bj, At, Bt) do { __builtin_amdgcn_s_setprio(1); _Pragma("unroll") for (int m = 0; m < 4; ++m) _Pragma("unroll") for (int n = 0; n < 2; ++n) _Pragma("unroll") for (int k = 0; k < 2; ++k) \
        acc[ai][bj][m][n] = __builtin_amdgcn_mfma_f32_16x16x32_bf16(Bt[n][k], At[m][k], acc[ai][bj][m][n], 0, 0, 0); __builtin_amdgcn_s_setprio(0); } while (0)
#define PG8_WAIT_V(n) asm volatile("s_waitcnt vmcnt(" #n ")" ::: "memory")
#define PG8_WAIT_L(n) asm volatile("s_waitcnt lgkmcnt(" #n ")" ::: "memory")
#define PG8_BAR __builtin_amdgcn_s_barrier()
#define PG8_SCHED __builtin_amdgcn_sched_barrier(0)
    Unit cur, nxt; int ui = 0;
    if (!S.next(0, cur)) return;
    f32x4 acc[2][2][4][2];
#pragma unroll
    for (int a = 0; a < 2; ++a)
#pragma unroll
        for (int b = 0; b < 2; ++b)
#pragma unroll
            for (int m = 0; m < 4; ++m)
#pragma unroll
                for (int n = 0; n < 2; ++n) acc[a][b][m][n] = (f32x4){0.f, 0.f, 0.f, 0.f};
    bf16x8 At[4][2], B0[2][2], B1[2][2];
    const char* cA = S.abase(cur); const char* cB = S.bbase(cur);
    if constexpr (SP2) {
        PG8_STAGEB(PG8_SB(0, 0), cB); PG8_STAGEB(PG8_SB(0, 1), cB + hstepB); PG8_STAGEA(PG8_SA(0, 0), cA); PG8_STAGEA(PG8_SA(0, 1), cA + hstepA);
        if (wr == 1) PG8_BAR;
        PG8_WAIT_V(2); PG8_BAR;
        PG8_STAGEB(PG8_SB(1, 0), cB + kstepB); PG8_STAGEA(PG8_SA(1, 0), cA + kstepA); PG8_STAGEB(PG8_SB(1, 1), cB + hstepB + kstepB);
        PG8_WAIT_V(6); PG8_BAR;
    } else {
        PG8_STAGEB(PG8_SB(0, 0), cB); PG8_STAGEA(PG8_SA(0, 0), cA); PG8_STAGEB(PG8_SB(0, 1), cB + hstepB); PG8_STAGEA(PG8_SA(0, 1), cA + hstepA);
        if (wr == 1) PG8_BAR;
        PG8_WAIT_V(4); PG8_BAR;
        PG8_STAGEB(PG8_SB(1, 0), cB + kstepB); PG8_STAGEA(PG8_SA(1, 0), cA + kstepA); PG8_STAGEB(PG8_SB(1, 1), cB + hstepB + kstepB);
        PG8_WAIT_V(6); PG8_BAR;
    }
    for (;;) {
        const bool has_next = S.next(ui + 1, nxt);
        const char* nA = has_next ? S.abase(nxt) : cA; const char* nB = has_next ? S.bbase(nxt) : cB;
        for (int t = 0; t < nt; t += 2) {
            if constexpr (Epi::MID) { if (t == (nt >> 1)) E.mid(acc, cur, wr, wc, fr, fq); }
            const bool last = (t == nt - 2);
            const char* a1 = cA + (size_t)(t + 1) * kstepA;
            const char* a2 = last ? nA : cA + (size_t)(t + 2) * kstepA; const char* b2 = last ? nB : cB + (size_t)(t + 2) * kstepB;
            const char* a3 = a2 + kstepA; const char* b3 = b2 + kstepB;
            if constexpr (SP2) {
            PG8_LDB(B0, 0, 0); PG8_LDB(B1, 0, 1); PG8_SCHED; PG8_LDA(At, 0, 0); PG8_STAGEA(PG8_SA(1, 1), a1 + hstepA);
            PG8_WAIT_V(8); PG8_WAIT_L(0); PG8_BAR; PG8_MMA(0, 0, At, B0); PG8_MMA(0, 1, At, B1); PG8_BAR; PG8_SCHED;
            PG8_LDA(At, 0, 1); PG8_STAGEB(PG8_SB(0, 0), b2); PG8_STAGEB(PG8_SB(0, 1), b2 + hstepB); PG8_STAGEA(PG8_SA(0, 0), a2);
            PG8_WAIT_V(8); PG8_WAIT_L(0); PG8_BAR; PG8_MMA(1, 0, At, B0); PG8_MMA(1, 1, At, B1); PG8_BAR; PG8_SCHED;
            PG8_LDB(B0, 1, 0); PG8_LDB(B1, 1, 1); PG8_SCHED; PG8_LDA(At, 1, 0); PG8_STAGEA(PG8_SA(0, 1), a2 + hstepA);
            PG8_WAIT_V(8); PG8_WAIT_L(0); PG8_BAR; PG8_MMA(0, 0, At, B0); PG8_MMA(0, 1, At, B1); PG8_BAR; PG8_SCHED;
            PG8_LDA(At, 1, 1); PG8_STAGEB(PG8_SB(1, 0), b3); PG8_STAGEB(PG8_SB(1, 1), b3 + hstepB); PG8_STAGEA(PG8_SA(1, 0), a3);
            PG8_WAIT_V(8); PG8_WAIT_L(0); PG8_BAR; PG8_MMA(1, 0, At, B0); PG8_MMA(1, 1, At, B1); PG8_BAR; PG8_SCHED;
            } else {
            PG8_LDB(B0, 0, 0); PG8_SCHED; PG8_LDA(At, 0, 0); PG8_STAGEA(PG8_SA(1, 1), a1 + hstepA);
            PG8_WAIT_L(8); PG8_BAR; PG8_WAIT_L(0); PG8_MMA(0, 0, At, B0); PG8_BAR; PG8_SCHED;
            PG8_LDB(B1, 0, 1); PG8_STAGEB(PG8_SB(0, 0), b2);
            PG8_BAR; PG8_WAIT_L(0); PG8_MMA(0, 1, At, B1); PG8_BAR;
            PG8_LDA(At, 0, 1); PG8_STAGEA(PG8_SA(0, 0), a2);
            PG8_BAR; PG8_WAIT_L(0); PG8_MMA(1, 0, At, B0); PG8_BAR; PG8_SCHED;
            PG8_STAGEB(PG8_SB(0, 1), b2 + hstepB);
            PG8_WAIT_V(6); PG8_BAR; PG8_MMA(1, 1, At, B1); PG8_BAR;
            PG8_LDB(B0, 1, 0); PG8_SCHED; PG8_LDA(At, 1, 0); PG8_STAGEA(PG8_SA(0, 1), a2 + hstepA);
            PG8_WAIT_L(8); PG8_BAR; PG8_WAIT_L(0); PG8_MMA(0, 0, At, B0); PG8_BAR; PG8_SCHED;
            PG8_LDB(B1, 1, 1); PG8_STAGEB(PG8_SB(1, 0), b3);
            PG8_BAR; PG8_WAIT_L(0); PG8_MMA(0, 1, At, B1); PG8_BAR;
            PG8_LDA(At, 1, 1); PG8_STAGEA(PG8_SA(1, 0), a3);
            PG8_BAR; PG8_WAIT_L(0); PG8_MMA(1, 0, At, B0); PG8_BAR; PG8_SCHED;
            PG8_STAGEB(PG8_SB(1, 1), b3 + hstepB);
            PG8_WAIT_V(6); PG8_BAR; PG8_MMA(1, 1, At, B1); PG8_BAR;
            }
        }
        if constexpr (ALIGN_EPI) { if (wr == 0) PG8_BAR; }
        if constexpr (!Epi::AFTER_DRAIN) { E(acc, cur, wr, wc, fr, fq); }
        if (!has_next) break;
#pragma unroll
        for (int a = 0; a < 2; ++a)
#pragma unroll
            for (int b = 0; b < 2; ++b)
#pragma unroll
                for (int m = 0; m < 4; ++m)
#pragma unroll
                    for (int n = 0; n < 2; ++n) acc[a][b][m][n] = (f32x4){0.f, 0.f, 0.f, 0.f};
        cur = nxt; cA = nA; cB = nB; ++ui;
        if constexpr (ALIGN_EPI) { if (wr == 1) PG8_BAR; }
    }
    PG8_WAIT_V(0);
    if constexpr (!ALIGN_EPI) { if (wr == 0) PG8_BAR; }
    PG8_BAR;
    if constexpr (Epi::AFTER_DRAIN) { E.fused(acc, cur, wr, wc, fr, fq, lds, wid, lane); }
#undef PG8_SA
#undef PG8_SB
#undef PG8_STAGEX
#undef PG8_STAGEA
#undef PG8_STAGEB
#undef PG8_LDA
#undef PG8_LDB
#undef PG8_MMA
#undef PG8_WAIT_V
#undef PG8_WAIT_L
#undef PG8_BAR
#undef PG8_SCHED
}
}

#define XB_TMO      128
#define XB_XCNT(j)  (256  + 64 * (j))
#define XB_XSUB(j)  (1280 + 64 * (j))
#define XB_XGEN(j)  (2304 + 64 * (j))
#define XB_TOP      3328
#define XB_TOPGEN   3392
#define XCD_BAR_WORDS 3456
#define XB_SPIN_CAP (1u << 18)
__device__ __forceinline__ unsigned xb_ld(unsigned* p)              { return __hip_atomic_load(p, __ATOMIC_RELAXED, __HIP_MEMORY_SCOPE_AGENT); }
__device__ __forceinline__ unsigned xb_add(unsigned* p, unsigned v) { return __hip_atomic_fetch_add(p, v, __ATOMIC_RELAXED, __HIP_MEMORY_SCOPE_AGENT); }
__device__ __forceinline__ unsigned xb_xcc_id() { return (unsigned)__builtin_amdgcn_s_getreg((3 << 11) | 20) & 0xFu; }
#define XB_SPIN(cond, bar) do { unsigned _sp = 0; while (cond) { __builtin_amdgcn_s_sleep(1); \
    if ((++_sp & 255u) == 0u) { if (xb_ld(&(bar)[XB_TMO])) break; if (_sp > XB_SPIN_CAP) { atomicAdd(&(bar)[XB_TMO], 1u); break; } } } } while (0)
struct XcdBarrier { unsigned* bar; unsigned x; volatile LAS unsigned* st; };
__device__ __forceinline__ XcdBarrier xcd_barrier_post(unsigned* bar, volatile LAS unsigned* st) {
    XcdBarrier b; b.bar = bar; b.x = xb_xcc_id(); b.st = st;
    if (threadIdx.x == 0) (void)xb_add(&bar[XB_XCNT(b.x)], 1u);
    return b;
}
__device__ __forceinline__ void xcd_barrier_complete(unsigned* bar, unsigned x, unsigned& nloc, unsigned& nx) {
    const unsigned G = gridDim.x * gridDim.y * gridDim.z;
    unsigned sum, cnt, mine, sp = 0u;
    for (;;) {
        sum = 0u; cnt = 0u; mine = 0u;
#pragma unroll
        for (unsigned j = 0; j < 16; ++j) { const unsigned c = xb_ld(&bar[XB_XCNT(j)]); sum += c; cnt += (c > 0u) ? 1u : 0u; mine = (j == x) ? c : mine; }
        if (sum == G) break;
        __builtin_amdgcn_s_sleep(1);
        if ((++sp & 255u) == 0u) { if (xb_ld(&bar[XB_TMO])) break; if (sp > XB_SPIN_CAP) { atomicAdd(&bar[XB_TMO], 1u); break; } }
    }
    nloc = mine > 0u ? mine : 1u; nx = cnt > 0u ? cnt : 1u;
}
__device__ __forceinline__ void xcd_barrier(const XcdBarrier& b) {
    asm volatile("s_waitcnt vmcnt(0)" ::: "memory");
    __syncthreads();
    if (threadIdx.x == 0) {
        unsigned* bar = b.bar;
        __builtin_amdgcn_s_waitcnt(0);
        unsigned nloc = b.st[0], nx = b.st[1];
        if (nloc == 0u) { xcd_barrier_complete(bar, b.x, nloc, nx); b.st[0] = nloc; b.st[1] = nx; }
        const unsigned old = xb_add(&bar[XB_XSUB(b.x)], 1u);
        const unsigned gen = old / nloc;
        if (old + 1u == (gen + 1u) * nloc) {
            __builtin_amdgcn_fence(__ATOMIC_RELEASE, "agent");
            asm volatile("s_waitcnt vmcnt(0)" ::: "memory");
            const unsigned og = xb_add(&bar[XB_TOP], 1u);
            const unsigned tg = og / nx;
            if (og + 1u == (tg + 1u) * nx) xb_add(&bar[XB_TOPGEN], 1u);
            else XB_SPIN(xb_ld(&bar[XB_TOPGEN]) == tg, bar);
            __builtin_amdgcn_fence(__ATOMIC_ACQUIRE, "agent");
            xb_add(&bar[XB_XGEN(b.x)], 1u);
            asm volatile("s_waitcnt vmcnt(0)" ::: "memory");
        } else {
            XB_SPIN(xb_ld(&bar[XB_XGEN(b.x)]) == gen, bar);
            __builtin_amdgcn_fence(__ATOMIC_ACQUIRE, "agent");
            asm volatile("s_waitcnt vmcnt(0)" ::: "memory");
        }
    }
    __syncthreads();
}

template <class Work>
__device__ __forceinline__ void xcd_barrier_shadow(const XcdBarrier& b, const Work& work) {
    asm volatile("s_waitcnt vmcnt(0)" ::: "memory");
    __syncthreads();
    if (threadIdx.x >= 64) work();
    else if (threadIdx.x == 0) {
        unsigned* bar = b.bar;
        __builtin_amdgcn_s_waitcnt(0);
        unsigned nloc = b.st[0], nx = b.st[1];
        if (nloc == 0u) { xcd_barrier_complete(bar, b.x, nloc, nx); b.st[0] = nloc; b.st[1] = nx; }
        const unsigned old = xb_add(&bar[XB_XSUB(b.x)], 1u);
        const unsigned gen = old / nloc;
        if (old + 1u == (gen + 1u) * nloc) {
            __builtin_amdgcn_fence(__ATOMIC_RELEASE, "agent");
            asm volatile("s_waitcnt vmcnt(0)" ::: "memory");
            const unsigned og = xb_add(&bar[XB_TOP], 1u);
            const unsigned tg = og / nx;
            if (og + 1u == (tg + 1u) * nx) xb_add(&bar[XB_TOPGEN], 1u);
            else XB_SPIN(xb_ld(&bar[XB_TOPGEN]) == tg, bar);
            __builtin_amdgcn_fence(__ATOMIC_ACQUIRE, "agent");
            xb_add(&bar[XB_XGEN(b.x)], 1u);
            asm volatile("s_waitcnt vmcnt(0)" ::: "memory");
        } else {
            XB_SPIN(xb_ld(&bar[XB_XGEN(b.x)]) == gen, bar);
            __builtin_amdgcn_fence(__ATOMIC_ACQUIRE, "agent");
            asm volatile("s_waitcnt vmcnt(0)" ::: "memory");
        }
    }
    __syncthreads();
}

constexpr int NWAVES = 8;
constexpr int RING_BYTES = 131072, LDSCTL_OFF = RING_BYTES, MISC_OFF = LDSCTL_OFF + 320, LDS_BYTES = 163840;
constexpr int CW_BAR = 4096, CW_CTXROWS = 16384, CW_GEMV = 16384 + 256;

struct Ptrs {
    const float *x, *c, *ctx, *cctx, *ada_w, *ada_b, *n1g, *n2g, *w_in, *pool_w, *pool_scale, *qg, *kg, *rpb, *wbp, *wbn, *w_out, *w1, *w2;
    float* out; unsigned char* ws;
    float *modp, *mod, *bias2, *rowp; f32x2* tab;
    bf16_t *wtin, *wtbr, *wtout, *wt1, *wt2, *kc, *vct, *xn, *u, *qr, *qp, *kr, *vt, *sgp, *sgn, *dn, *mg, *xg, *xnb, *h; float *tmp, *zc;
};
struct Args { const float* in[19]; float* out; unsigned char* ws; int ph_lo, ph_hi, li, pad; };
__device__ __forceinline__ Ptrs make_ptrs(const Args& a) {
    Ptrs P;
    P.x = a.in[0]; P.c = a.in[1]; P.ctx = a.in[2]; P.cctx = a.in[3]; P.ada_w = a.in[4]; P.ada_b = a.in[5]; P.n1g = a.in[6]; P.n2g = a.in[7]; P.w_in = a.in[8]; P.pool_w = a.in[9];
    P.pool_scale = a.in[10]; P.qg = a.in[11]; P.kg = a.in[12]; P.rpb = a.in[13]; P.wbp = a.in[14]; P.wbn = a.in[15]; P.w_out = a.in[16]; P.w1 = a.in[17]; P.w2 = a.in[18];
    P.out = a.out; P.ws = a.ws; unsigned char* ws = a.ws;
    P.modp = (float*)(ws + WS_SMALL + OFF_MODP); P.mod = (float*)(ws + WS_SMALL + OFF_MOD); P.tab = (f32x2*)(ws + WS_SMALL + OFF_TAB);
    P.bias2 = (float*)(ws + WS_SMALL + OFF_BIAS2); P.rowp = (float*)(ws + WS_ROWP);
    P.wtin = (bf16_t*)(ws + WS_WTIN); P.wtbr = (bf16_t*)(ws + WS_WTBR); P.wtout = (bf16_t*)(ws + WS_WTOUT); P.wt1 = (bf16_t*)(ws + WS_WT1); P.wt2 = (bf16_t*)(ws + WS_WT2);
    P.kc = (bf16_t*)(ws + WS_KC); P.vct = (bf16_t*)(ws + WS_VCT); P.xn = (bf16_t*)(ws + WS_XN);
    P.u = (bf16_t*)(ws + WS_U); P.qr = (bf16_t*)(ws + WS_QR); P.qp = (bf16_t*)(ws + WS_QP); P.kr = (bf16_t*)(ws + WS_KR); P.vt = (bf16_t*)(ws + WS_VT);
    P.sgp = (bf16_t*)(ws + WS_SGP); P.sgn = (bf16_t*)(ws + WS_SGN); P.dn = (bf16_t*)(ws + WS_DN); P.mg = (bf16_t*)(ws + WS_MG); P.xnb = (bf16_t*)(ws + WS_XG); P.xg = (bf16_t*)a.out; P.h = (bf16_t*)(ws + WS_H);
    P.tmp = (float*)(ws + WS_TMP); P.zc = (float*)(ws + WS_ZC);
    return P;
}
struct Frame { LAS unsigned char* lds; int tid, lane, wave, vcu, G; };

template <class WMap>
__device__ __forceinline__ void wave_gemm_acc(const bf16_t* A, int lda, const bf16_t* Bt, int ldb, int K, int row0, const WMap& wmap, f32x16& d0, f32x16& d1, int lane) {
    const int r = lane & 31, hi = lane >> 5;
    const bf16_t* ap = A + (size_t)(row0 + r) * lda + 8 * hi;
    const bf16_t* bp0 = Bt + (size_t)wmap(r) * ldb + 8 * hi;
    const bf16_t* bp1 = Bt + (size_t)wmap(32 + r) * ldb + 8 * hi;
    bf16x8 a[4], b0[4], b1[4], an[4], b0n[4], b1n[4];
#define WG_LOAD(A_, B0_, B1_, k_) do { _Pragma("unroll") for (int i = 0; i < 4; ++i) { A_[i] = *(const bf16x8*)(ap + (k_) + 16 * i); B0_[i] = *(const bf16x8*)(bp0 + (k_) + 16 * i); B1_[i] = *(const bf16x8*)(bp1 + (k_) + 16 * i); } } while (0)
#define WG_MMA(A_, B0_, B1_) do { _Pragma("unroll") for (int i = 0; i < 4; ++i) { d0 = __builtin_amdgcn_mfma_f32_32x32x16_bf16(B0_[i], A_[i], d0, 0, 0, 0); d1 = __builtin_amdgcn_mfma_f32_32x32x16_bf16(B1_[i], A_[i], d1, 0, 0, 0); } } while (0)
    WG_LOAD(a, b0, b1, 0);
    for (int k = 0; k < K; k += 128) {
        WG_LOAD(an, b0n, b1n, k + 64);
        WG_MMA(a, b0, b1);
        if (k + 128 < K) WG_LOAD(a, b0, b1, k + 128);
        WG_MMA(an, b0n, b1n);
    }
#undef WG_LOAD
#undef WG_MMA
}
__device__ __forceinline__ int dcol(int blk, int reg, int hi) { return 32 * blk + (reg & 3) + 8 * (reg >> 2) + 4 * hi; }

__device__ __forceinline__ void head_norm_rope(const f32x16& d0, const f32x16& d1, const float* g, const f32x2* tab, int t, int hi, f32x16& y0, f32x16& y1, f32x16& r0, f32x16& r1) {
    float ss = 0.f;
#pragma unroll
    for (int i = 0; i < 16; ++i) ss += d0[i] * d0[i] + d1[i] * d1[i];
    ss += __shfl_xor(ss, 32);
    const float rstd = rsqrtf(ss * (1.0f / 64.0f) + EPS);
#pragma unroll
    for (int i = 0; i < 16; ++i) { y0[i] = d0[i] * rstd * g[dcol(0, i, hi)]; y1[i] = d1[i] * rstd * g[dcol(1, i, hi)]; }
    const int prow = t >> 6, pcol = t & 63;
#pragma unroll
    for (int i = 0; i < 8; ++i) {
        const int di = (i & 3) + 8 * (i >> 2) + 4 * hi;
        const f32x2 cr = tab[prow * 16 + di], cc = tab[pcol * 16 + di];
        r0[i] = y0[i] * cr.x - y0[i + 8] * cr.y; r0[i + 8] = y0[i] * cr.y + y0[i + 8] * cr.x;
        r1[i] = y1[i] * cc.x - y1[i + 8] * cc.y; r1[i + 8] = y1[i] * cc.y + y1[i + 8] * cc.x;
    }
}

template <class RM>
__device__ __forceinline__ void tr_item(const float* W, int ldw, int k0, int n0, bf16_t* Dst, int ldd, int koff, const RM& rm, LAS float* scr, int lane) {
    const int kr = lane >> 3, c4 = lane & 7;
    f32x4 v[8];
#pragma unroll
    for (int i = 0; i < 8; ++i) v[i] = __builtin_nontemporal_load((const f32x4*)(W + (size_t)(k0 + 8 * i + kr) * ldw + n0 + 4 * c4));
#pragma unroll
    for (int i = 0; i < 8; ++i) { LAS float* d = scr + (8 * i + kr) * 33 + 4 * c4; d[0] = v[i][0]; d[1] = v[i][1]; d[2] = v[i][2]; d[3] = v[i][3]; }
    LDS_WAIT(); asm volatile("" ::: "memory");
    const int c = lane & 7;
#pragma unroll
    for (int j = 0; j < 4; ++j) { const int n = (lane >> 3) + 8 * j; const LAS float* s = scr + (8 * c) * 33 + n;
        u32x4 o; o.x = pk2(s[0 * 33], s[1 * 33]); o.y = pk2(s[2 * 33], s[3 * 33]); o.z = pk2(s[4 * 33], s[5 * 33]); o.w = pk2(s[6 * 33], s[7 * 33]);
        *(u32x4*)(Dst + (size_t)rm(n0 + n) * ldd + koff + k0 + 8 * c) = o; }
    LDS_WAIT(); asm volatile("" ::: "memory");
}
struct RmIn { __device__ __forceinline__ int operator()(int n) const { return wrow_in(n); } };
struct RmStd { __device__ __forceinline__ int operator()(int n) const { return wrow_std(n); } };

__device__ __forceinline__ void late_tiles(const Frame& F, const Ptrs& P, int first, int count, int W) {
    const int w = F.wave - 1; if (w < 0 || w >= W) return;
    LAS float* scr = (LAS float*)(F.lds + w * 8704);
    for (int i = F.vcu * W + w; i < count; i += F.G * W) {
        int t = first + i; const float* src; bf16_t* dst; int ldw, ldd, nb;
        if (t < 256) { src = P.wbn; dst = P.wtbr + 512; ldw = DM; ldd = DM; nb = 32; }
        else if ((t -= 256) < 2048) { src = P.w1; dst = P.wt1; ldw = FF; ldd = DM; nb = 128; }
        else if ((t -= 2048) < 512) { src = P.w_out; dst = P.wtout; ldw = DM; ldd = DM; nb = 32; }
        else { t -= 512; src = P.w2; dst = P.wt2; ldw = DM; ldd = FF; nb = 32; }
        tr_item(src, ldw, 64 * (t / nb), 32 * (t % nb), dst, ldd, 0, RmStd(), scr, F.lane);
    }
}

__device__ __forceinline__ void phase0(const Frame& F, const Ptrs& P) {
    for (int bit = F.vcu; bit < 193; bit += F.G) {
      if (bit < 192) {
        const int cb = bit % 48, kq = bit / 48;
        LAS float* sl = (LAS float*)F.lds;
        for (int i = F.tid; i < 768; i += 512) { const int v = i >> 8, k = kq * 256 + (i & 255); const float cv = (v == 0) ? P.c[k] : (v == 1) ? P.c[DM + k] : P.cctx[k]; sl[i] = siluf_(cv); }
        __syncthreads();
        const int col = cb * 128 + (F.tid & 127), kg = F.tid >> 7;
        float a0 = 0.f, a1 = 0.f, a2 = 0.f;
        const float* wp = P.ada_w + (size_t)(kq * 256 + kg * 64) * 6144 + col;
        float wv[64];
#pragma unroll
        for (int k = 0; k < 64; ++k) wv[k] = __builtin_nontemporal_load(wp + (size_t)k * 6144);
#pragma unroll
        for (int k = 0; k < 64; ++k) { const float w = wv[k]; const int kk = kg * 64 + k; a0 += sl[kk] * w; a1 += sl[256 + kk] * w; a2 += sl[512 + kk] * w; }
        LAS float* pr = (LAS float*)F.lds + 1024;
        pr[(kg * 3 + 0) * 128 + (F.tid & 127)] = a0; pr[(kg * 3 + 1) * 128 + (F.tid & 127)] = a1; pr[(kg * 3 + 2) * 128 + (F.tid & 127)] = a2;
        __syncthreads();
        if (F.tid < 384) { const int v = F.tid >> 7, cl = F.tid & 127; const float s = (pr[(0 * 3 + v) * 128 + cl] + pr[(1 * 3 + v) * 128 + cl]) + (pr[(2 * 3 + v) * 128 + cl] + pr[(3 * 3 + v) * 128 + cl]);
            __hip_atomic_store(P.modp + (size_t)(kq * 3 + v) * 6144 + cb * 128 + cl, s, __ATOMIC_RELAXED, __HIP_MEMORY_SCOPE_AGENT); }
        asm volatile("s_waitcnt vmcnt(0)" ::: "memory");
        __syncthreads();
        if (F.tid == 0) __hip_atomic_fetch_add((unsigned*)(P.ws + WS_CTL) + CW_GEMV, 1u, __ATOMIC_RELAXED, __HIP_MEMORY_SCOPE_AGENT);
      } else {
        for (int i = F.tid; i < 128 * 16; i += 512) { const int pos = i >> 4, fi = i & 15; const float inv = powf(10000.0f, -(float)fi / 16.0f); const float ang = (float)pos * inv; float sn, cs; sincosf(ang, &sn, &cs); P.tab[i] = (f32x2){cs, sn}; }
      }
    }
    {
        LAS float* ts = (LAS float*)(F.lds + 16384);
        const bool full = F.G > 224;
        struct TrDesc { const float* src; bf16_t* dst; int ldw, ldd, k0, n0, isin; };
        auto item_of = [&](int rep) {
            int it;
            if (full) {
                if (F.vcu < 32) { if (rep >= 4) return 1 << 30; it = -(1 + 4 * (F.vcu >> 3) + rep); }
                else if (F.vcu < 192) { if (rep >= 1 || F.vcu >= 96) return 1 << 30; it = 128 + (F.vcu - 32); }
                else { if (rep >= 2 || F.vcu >= 256) return 1 << 30; it = (F.vcu - 192) + rep * 64; }
            } else { it = F.vcu + rep * F.G - 64; if (it < 0) it = -(1 + (it + 64)); }
            return it >= 192 ? (1 << 30) : it; };
        auto desc_of = [&](int it) { TrDesc d; int r = it;
            if (r < 0) { const int sp = -1 - r, kb = sp & 15, pnx = full ? (F.vcu & 3) : (sp >> 4); d.src = P.w_in; d.ldw = INW; d.k0 = 64 * kb; d.n0 = 256 * (4 + pnx); d.dst = P.wtin; d.ldd = DM; d.isin = 1; }
            else { const int nti = r % 12; d.src = P.w_in; d.ldw = INW; d.k0 = 64 * (r / 12); d.n0 = 256 * (nti < 4 ? nti : nti + 4); d.dst = P.wtin; d.ldd = DM; d.isin = 1; }
            return d; };
#define TRB_LOAD(v_, d_) do { _Pragma("unroll") for (int j = 0; j < 8; ++j) v_[j] = __builtin_nontemporal_load((const f32x4*)(d_.src + (size_t)(d_.k0 + F.wave + 8 * j) * d_.ldw + d_.n0 + 4 * F.lane)); } while (0)
#define TRB_FINISH(v_, d_) do { \
            _Pragma("unroll") for (int j = 0; j < 8; ++j) { LAS float* q_ = ts + (F.lane >> 3) * 2113 + (F.wave + 8 * j) * 33 + 4 * (F.lane & 7); q_[0] = v_[j][0]; q_[1] = v_[j][1]; q_[2] = v_[j][2]; q_[3] = v_[j][3]; } \
            __syncthreads(); \
            { const int c_ = F.tid & 7; \
              _Pragma("unroll") for (int j = 0; j < 4; ++j) { const int n_ = (F.tid >> 3) + 64 * j; const LAS float* q_ = ts + (n_ >> 5) * 2113 + (8 * c_) * 33 + (n_ & 31); \
                u32x4 o_; o_.x = pk2(q_[0 * 33], q_[1 * 33]); o_.y = pk2(q_[2 * 33], q_[3 * 33]); o_.z = pk2(q_[4 * 33], q_[5 * 33]); o_.w = pk2(q_[6 * 33], q_[7 * 33]); \
                const int row_ = d_.isin ? wrow_in(d_.n0 + n_) : wrow_std(d_.n0 + n_); *(u32x4*)(d_.dst + (size_t)row_ * d_.ldd + d_.k0 + 8 * c_) = o_; } } \
            __syncthreads(); } while (0)
        {
            f32x4 va[8], vb[8]; TrDesc da, db; int rep = 0;
            int ia = item_of(0);
            if (ia != (1 << 30)) { da = desc_of(ia); TRB_LOAD(va, da); }
            while (ia != (1 << 30)) {
                const int ib = item_of(rep + 1);
                if (ib != (1 << 30)) { db = desc_of(ib); TRB_LOAD(vb, db); }
                TRB_FINISH(va, da);
                if (ib == (1 << 30)) break;
                ia = item_of(rep + 2);
                if (ia != (1 << 30)) { da = desc_of(ia); TRB_LOAD(va, da); }
                TRB_FINISH(vb, db);
                rep += 2;
            }
        }
#undef TRB_LOAD
#undef TRB_FINISH
    }
}

__device__ __forceinline__ void fold_items(const Frame& F, const Ptrs& P) {
    if (F.wave < 4) return;
    LAS float* scr = (LAS float*)(F.lds + 16384 + F.wave * 12288);
    for (int r = F.vcu * 4 + F.wave - 4; r < 1024; r += F.G * 4) {
        const int n = (r & 15) * 64 + F.lane, chunk = r >> 4, g = chunk >> 4, c0 = (chunk & 15) * 8;
#pragma unroll
        for (int q = 0; q < 4; ++q) { const int idx = q * 256 + F.lane * 4; *(LAS f32x4*)(scr + idx) = *(const f32x4*)(P.pool_w + (size_t)(g * 128 + c0) * 128 + idx); }
        *(LAS f32x2*)(scr + 1024 + 2 * F.lane) = *(const f32x2*)(P.pool_scale + g * 128 + 2 * F.lane);
        LDS_WAIT(); asm volatile("" ::: "memory");
        float acc[8];
#pragma unroll
        for (int i = 0; i < 8; ++i) acc[i] = 0.f;
        const float* wp = P.wbp + (size_t)(g * 128) * DM + n;
        for (int e0 = 0; e0 < 128; e0 += 64) {
            float wv[64];
#pragma unroll
            for (int e = 0; e < 64; ++e) wv[e] = __builtin_nontemporal_load(wp + (size_t)(e0 + e) * DM);
#pragma unroll
            for (int e = 0; e < 64; ++e) { const float w = wv[e] * scr[1024 + e0 + e];
#pragma unroll
                for (int i = 0; i < 8; ++i) acc[i] += scr[i * 128 + e0 + e] * w; }
        }
        u32x4 o; o.x = pk2(acc[0], acc[1]); o.y = pk2(acc[2], acc[3]); o.z = pk2(acc[4], acc[5]); o.w = pk2(acc[6], acc[7]);
        *(u32x4*)(P.wtbr + (size_t)wrow_std(n) * DM + g * 128 + c0) = o;
        LDS_WAIT(); asm volatile("" ::: "memory");
    }
}

__device__ __forceinline__ float modsum(const float* modp, int v, int col) { return (modp[(size_t)(0 * 3 + v) * 6144 + col] + modp[(size_t)(1 * 3 + v) * 6144 + col]) + (modp[(size_t)(2 * 3 + v) * 6144 + col] + modp[(size_t)(3 * 3 + v) * 6144 + col]); }
__device__ __forceinline__ void phase1(const Frame& F, const Ptrs& P) {
    const bool ctxwg = (F.G > 32) && (F.vcu < 32);
    const int gwl = (F.G > 32 ? F.vcu - 32 : F.vcu) * NWAVES + F.wave, NGWL = ((F.G > 32) ? F.G - 32 : F.G) * NWAVES;
    const int nitv = (SEQ + 5 * NGWL - 1) / (5 * NGWL), NIT = 2 * nitv;
    LAS float* tb = (LAS float*)F.lds;
#define ROWS_LOAD(xv_, it_) do { const int v_ = (it_) / nitv, m0_ = gwl + ((it_) % nitv) * 5 * NGWL; \
        _Pragma("unroll") for (int q = 0; q < 5; ++q) { const int m = min(m0_ + q * NGWL, SEQ - 1); const float* xrow = P.x + ((size_t)v_ * SEQ + m) * DM; \
            _Pragma("unroll") for (int j = 0; j < 4; ++j) xv_[q][j] = __builtin_nontemporal_load((const f32x4*)(xrow + 256 * j + 4 * F.lane)); } } while (0)
#define ROWS_FINISH(xv_, it_) do { const int v_ = (it_) / nitv, m0_ = gwl + ((it_) % nitv) * 5 * NGWL; f32x4 sc[4], sh[4]; \
        _Pragma("unroll") for (int j = 0; j < 4; ++j) { sc[j] = *(const LAS f32x4*)(tb + (v_ * 2 + 0) * 1024 + 256 * j + 4 * F.lane); sh[j] = *(const LAS f32x4*)(tb + (v_ * 2 + 1) * 1024 + 256 * j + 4 * F.lane); } \
        _Pragma("unroll") for (int q = 0; q < 5; ++q) { const int m = m0_ + q * NGWL; if (m < SEQ) { \
            bf16_t* orow = P.xn + ((size_t)v_ * SEQ + m) * DM; float sq = 0.f; \
            _Pragma("unroll") for (int j = 0; j < 4; ++j) sq += (xv_[q][j].x * xv_[q][j].x + xv_[q][j].y * xv_[q][j].y) + (xv_[q][j].z * xv_[q][j].z + xv_[q][j].w * xv_[q][j].w); \
            const float rstd = rsqrtf(wave_sum(sq) * (1.0f / DM) + EPS); \
            _Pragma("unroll") for (int j = 0; j < 4; ++j) { const f32x4 o = xv_[q][j] * rstd * sc[j] + sh[j]; u32x2 w; w.x = pk2(o.x, o.y); w.y = pk2(o.z, o.w); *(u32x2*)(orow + 256 * j + 4 * F.lane) = w; } } } } while (0)
    f32x4 xa[5][4], xb[5][4], xc[4];
    if (!ctxwg) ROWS_LOAD(xa, 0);
    const int mc = F.vcu + F.G * F.wave;
    if (mc < MCTX) {
#pragma unroll
        for (int j = 0; j < 4; ++j) xc[j] = __builtin_nontemporal_load((const f32x4*)(P.ctx + (size_t)mc * DM + 256 * j + 4 * F.lane)); }
    if (F.tid == 0) { unsigned* c = (unsigned*)(P.ws + WS_CTL) + CW_GEMV; unsigned sp = 0;
        while (__hip_atomic_load(c, __ATOMIC_RELAXED, __HIP_MEMORY_SCOPE_AGENT) < 192u) { __builtin_amdgcn_s_sleep(2); if (++sp > (1u << 20)) break; }
        __builtin_amdgcn_fence(__ATOMIC_ACQUIRE, "agent"); asm volatile("s_waitcnt vmcnt(0)" ::: "memory"); }
    __syncthreads();
    for (int i = F.vcu * 512 + F.tid; i < 3 * 6144; i += F.G * 512) { const int v = i / 6144, col = i % 6144; P.mod[i] = modsum(P.modp, v, col) + P.ada_b[col]; }
#pragma unroll
    for (int i0 = 0; i0 < 3 * 1024; i0 += 512) { const int i = i0 + F.tid, v = i >> 10, col = i & 1023;
        tb[(v * 2 + 0) * 1024 + col] = P.n1g[col] * (1.0f + modsum(P.modp, v, 1024 + col) + P.ada_b[1024 + col]); tb[(v * 2 + 1) * 1024 + col] = modsum(P.modp, v, col) + P.ada_b[col]; }
    __syncthreads();
    unsigned* cnt = (unsigned*)(P.ws + WS_CTL) + CW_CTXROWS;
    {
        f32x4 sc[4], sh[4];
#pragma unroll
        for (int j = 0; j < 4; ++j) { sc[j] = *(const LAS f32x4*)(tb + 4 * 1024 + 256 * j + 4 * F.lane); sh[j] = *(const LAS f32x4*)(tb + 5 * 1024 + 256 * j + 4 * F.lane); }
        for (int m = mc; m < MCTX; m += F.G * NWAVES) {
            bf16_t* orow = P.xn + ((size_t)MTOK + m) * DM;
            if (m != mc) {
#pragma unroll
                for (int j = 0; j < 4; ++j) xc[j] = __builtin_nontemporal_load((const f32x4*)(P.ctx + (size_t)m * DM + 256 * j + 4 * F.lane)); }
            float sq = 0.f;
#pragma unroll
            for (int j = 0; j < 4; ++j) sq += (xc[j].x * xc[j].x + xc[j].y * xc[j].y) + (xc[j].z * xc[j].z + xc[j].w * xc[j].w);
            const float rstd = rsqrtf(wave_sum(sq) * (1.0f / DM) + EPS);
#pragma unroll
            for (int j = 0; j < 4; ++j) { const f32x4 o = xc[j] * rstd * sc[j] + sh[j];
                __hip_atomic_store((unsigned long long*)(orow + 256 * j + 4 * F.lane), (unsigned long long)pk2(o.x, o.y) | ((unsigned long long)pk2(o.z, o.w) << 32), __ATOMIC_RELAXED, __HIP_MEMORY_SCOPE_AGENT); }
            asm volatile("s_waitcnt vmcnt(0)" ::: "memory");
            if (F.lane == 0) __hip_atomic_fetch_add(cnt + 64 * (m >> 8), 1u, __ATOMIC_RELAXED, __HIP_MEMORY_SCOPE_AGENT);
        }
    }
    if (!ctxwg) {
        for (int it = 0;;) {
            if (it + 1 < NIT) ROWS_LOAD(xb, it + 1);
            ROWS_FINISH(xa, it);
            if (it + 1 >= NIT) break;
            if (it + 2 < NIT) ROWS_LOAD(xa, it + 2);
            ROWS_FINISH(xb, it + 1);
            it += 2; if (it >= NIT) break;
        }
    }
#undef ROWS_LOAD
#undef ROWS_FINISH
    if (ctxwg) {
        if (F.tid == 0) { unsigned* c = cnt + 64 * ((F.vcu >> 2) & 1); unsigned sp = 0;
            while (__hip_atomic_load(c, __ATOMIC_RELAXED, __HIP_MEMORY_SCOPE_AGENT) < 256u) { __builtin_amdgcn_s_sleep(2); if (++sp > (1u << 20)) break; }
            __builtin_amdgcn_fence(__ATOMIC_ACQUIRE, "agent"); asm volatile("s_waitcnt vmcnt(0)" ::: "memory"); }
    }
    VM_WAIT();
    __syncthreads();
}
__device__ __forceinline__ void bias2_items(const Frame& F, const Ptrs& P, int gw, int NGW) {
    float h0[16], h1[16];
#pragma unroll
    for (int q = 0; q < 4; ++q) { const f32x4 a = *(const f32x4*)(P.mod + 3072 + 16 * F.lane + 4 * q), b = *(const f32x4*)(P.mod + 6144 + 3072 + 16 * F.lane + 4 * q);
#pragma unroll
        for (int e = 0; e < 4; ++e) { h0[4 * q + e] = a[e]; h1[4 * q + e] = b[e]; } }
    for (int p = gw; p < FF; p += NGW) {
        const bf16_t* wr = P.wt1 + (size_t)p * DM + 16 * F.lane;
        const u32x4 w0 = *(const u32x4*)wr, w1 = *(const u32x4*)(wr + 8);
        float wf[16]; wf[0] = bflo(w0.x); wf[1] = bfhi(w0.x); wf[2] = bflo(w0.y); wf[3] = bfhi(w0.y); wf[4] = bflo(w0.z); wf[5] = bfhi(w0.z); wf[6] = bflo(w0.w); wf[7] = bfhi(w0.w);
        wf[8] = bflo(w1.x); wf[9] = bfhi(w1.x); wf[10] = bflo(w1.y); wf[11] = bfhi(w1.y); wf[12] = bflo(w1.z); wf[13] = bfhi(w1.z); wf[14] = bflo(w1.w); wf[15] = bfhi(w1.w);
        float s0 = 0.f, s1 = 0.f;
#pragma unroll
        for (int e = 0; e < 16; ++e) { s0 += h0[e] * wf[e]; s1 += h1[e] * wf[e]; }
        s0 = wave_sum(s0); s1 = wave_sum(s1);
        if (F.lane == 0) { const int col = (p & ~255) | fwd_std(p & 255); P.bias2[col] = s0; P.bias2[FF + col] = s1; }
    }
}

__host__ __device__ __forceinline__ size_t kr_index(int b, int t, int h, int d) { const int r = t >> 6, col = t & 63, quad = col >> 2, eq = quad >> 1, par = quad & 1;
    return (size_t)((b * NROWS + r) * NH + h) * 4096 + ((((d >> 5) * 4 + ((d >> 3) & 3)) * 2 + par) * 2 + (eq >> 2)) * 128 + ((col & 3) * 4 + (eq & 3)) * 8 + (d & 7); }
__host__ __device__ __forceinline__ size_t vt_index(int b, int h, int d, int t) { const int r = t >> 6, col = t & 63;
    return (((size_t)((b * NROWS + r) * NH + h) * 8 + (col >> 3)) * 64 + d) * 8 + (col & 7); }

__host__ __device__ __forceinline__ size_t kc_index(int b, int n, int h, int d) { const int g = n >> 5, nn = n & 31, hb = (nn >> 2) & 1, m = 4 * (nn >> 3) + (nn & 3), s = d >> 5, fq = (d >> 3) & 3, j = d & 7;
    return (size_t)((((b * NH + h) * 8 + g) * 2 + hb) * 2 + s) * 512 + (m + 16 * fq) * 8 + j; }
__host__ __device__ __forceinline__ size_t vct_index(int b, int h, int d, int n) { const int g = n >> 5, fq = (n >> 3) & 3, j = n & 7, db = d >> 4, qi = d & 15;
    return (size_t)(((b * NH + h) * 8 + g) * 4 + db) * 512 + (qi + 16 * fq) * 8 + j; }

struct WmIn { int c0; __device__ __forceinline__ int operator()(int i) const { return wrow_in(c0 + i); } };
__device__ __forceinline__ void ctx_kv(const Frame& F, const Ptrs& P) {
    const int gw = F.vcu * NWAVES + F.wave, NGW = F.G * NWAVES;
    for (int it = gw; it < 256; it += NGW) {
        const int rt = it & 15, ht = it >> 4, row0 = rt * 32, hi = F.lane >> 5, r = F.lane & 31;
        f32x16 d0 = {}, d1 = {};
        WmIn wm{1024 + 64 * ht};
        wave_gemm_acc(P.xn + (size_t)MTOK * DM, DM, P.wtin, DM, DM, row0, wm, d0, d1, F.lane);
        const int crow = row0 + r;
        if (ht < 8) {
            float ss = 0.f;
#pragma unroll
            for (int i = 0; i < 16; ++i) ss += d0[i] * d0[i] + d1[i] * d1[i];
            ss += __shfl_xor(ss, 32);
            const float rstd = rsqrtf(ss * (1.0f / 64.0f) + EPS);
#pragma unroll
            for (int i = 0; i < 16; ++i) { const int c0 = dcol(0, i, hi), c1 = dcol(1, i, hi); P.kc[kc_index(crow >> 8, crow & 255, ht, c0)] = f2bf(d0[i] * rstd * P.kg[c0]); P.kc[kc_index(crow >> 8, crow & 255, ht, c1)] = f2bf(d1[i] * rstd * P.kg[c1]); }
        } else {
            const int h = ht - 8, b = crow >> 8, n = crow & 255;
#pragma unroll
            for (int i = 0; i < 16; ++i) { const int c0 = dcol(0, i, hi), c1 = dcol(1, i, hi); P.vct[vct_index(b, h, c0, n)] = f2bf(d0[i]); P.vct[vct_index(b, h, c1, n)] = f2bf(d1[i]); }
        }
    }
}

__device__ __forceinline__ void pool_item(const Ptrs& P, int row, int chunk) {
    const int b = row >> 13, t = row & (SEQ - 1), w = 2 << (chunk >> 4);
    const int lo = max(t - (w >> 1), 0), hi = min(t + (w >> 1), SEQ);
    float s[8];
#pragma unroll
    for (int i = 0; i < 8; ++i) s[i] = 0.f;
    for (int tt = lo; tt < hi; ++tt) { const u32x4 v = *(const u32x4*)(P.u + ((size_t)b * SEQ + tt) * PW + chunk * 8);
        s[0] += bflo(v.x); s[1] += bfhi(v.x); s[2] += bflo(v.y); s[3] += bfhi(v.y); s[4] += bflo(v.z); s[5] += bfhi(v.z); s[6] += bflo(v.w); s[7] += bfhi(v.w); }
    const u32x4 c = *(const u32x4*)(P.u + (size_t)row * PW + chunk * 8);
    const float inv = 1.0f / (float)(hi - lo);
    u32x4 o; o.x = pk2(s[0] * inv - bflo(c.x), s[1] * inv - bfhi(c.x)); o.y = pk2(s[2] * inv - bflo(c.y), s[3] * inv - bfhi(c.y));
    o.z = pk2(s[4] * inv - bflo(c.z), s[5] * inv - bfhi(c.z)); o.w = pk2(s[6] * inv - bflo(c.w), s[7] * inv - bfhi(c.w));
    *(u32x4*)(P.dn + (size_t)row * DM + chunk * 8) = o;
}
template <int W> __device__ __forceinline__ void pool_item_w(const Ptrs& P, int row, int chunk) {
    const int b = row >> 13, t = row & (SEQ - 1);
    const int lo = max(t - W / 2, 0), hi = min(t + W / 2, SEQ);
    u32x4 v[W];
#pragma unroll
    for (int i = 0; i < W; ++i) { const int tt = min(max(t - W / 2 + i, 0), SEQ - 1); v[i] = *(const u32x4*)(P.u + ((size_t)b * SEQ + tt) * PW + chunk * 8); }
    float s[8];
#pragma unroll
    for (int i = 0; i < 8; ++i) s[i] = 0.f;
#pragma unroll
    for (int i = 0; i < W; ++i) { const int tt = t - W / 2 + i; const float m = (tt >= 0 && tt < SEQ) ? 1.0f : 0.0f;
        s[0] += m * bflo(v[i].x); s[1] += m * bfhi(v[i].x); s[2] += m * bflo(v[i].y); s[3] += m * bfhi(v[i].y); s[4] += m * bflo(v[i].z); s[5] += m * bfhi(v[i].z); s[6] += m * bflo(v[i].w); s[7] += m * bfhi(v[i].w); }
    const u32x4 c = v[W / 2];
    const float inv = 1.0f / (float)(hi - lo);
    u32x4 o; o.x = pk2(s[0] * inv - bflo(c.x), s[1] * inv - bfhi(c.x)); o.y = pk2(s[2] * inv - bflo(c.y), s[3] * inv - bfhi(c.y));
    o.z = pk2(s[4] * inv - bflo(c.z), s[5] * inv - bfhi(c.z)); o.w = pk2(s[6] * inv - bflo(c.w), s[7] * inv - bfhi(c.w));
    *(u32x4*)(P.dn + (size_t)row * DM + chunk * 8) = o;
}

template <int W> __device__ __forceinline__ void pool_seg8(const Ptrs& P, int b, int t0, int chunk) {
    const bf16_t* ub = P.u + (size_t)b * SEQ * PW + chunk * 8;
    auto ld = [&](int t) { return *(const u32x4*)(ub + (size_t)min(max(t, 0), SEQ - 1) * PW); };
    auto acc = [&](float (&s)[8], const u32x4& v, float m) { s[0] += m * bflo(v.x); s[1] += m * bfhi(v.x); s[2] += m * bflo(v.y); s[3] += m * bfhi(v.y); s[4] += m * bflo(v.z); s[5] += m * bfhi(v.z); s[6] += m * bflo(v.w); s[7] += m * bfhi(v.w); };
    u32x4 w[W];
#pragma unroll
    for (int i = 0; i < W; ++i) w[i] = ld(t0 - W / 2 + i);
    u32x4 vin[7], vout[7], cen[8];
#pragma unroll
    for (int i = 0; i < 7; ++i) { vin[i] = ld(t0 + i + W / 2); vout[i] = ld(t0 + i - W / 2); }
#pragma unroll
    for (int i = 0; i < 8; ++i) cen[i] = (i < W / 2) ? w[W / 2 + i] : vin[i - W / 2];
    float s[8];
#pragma unroll
    for (int e = 0; e < 8; ++e) s[e] = 0.f;
#pragma unroll
    for (int i = 0; i < W; ++i) { const int t = t0 - W / 2 + i; acc(s, w[i], (t >= 0 && t < SEQ) ? 1.0f : 0.0f); }
#pragma unroll
    for (int i = 0; i < 8; ++i) {
        const int t = t0 + i, lo = max(t - W / 2, 0), hi = min(t + W / 2, SEQ);
        const float inv = 1.0f / (float)(hi - lo); const u32x4 c = cen[i];
        u32x4 o; o.x = pk2(s[0] * inv - bflo(c.x), s[1] * inv - bfhi(c.x)); o.y = pk2(s[2] * inv - bflo(c.y), s[3] * inv - bfhi(c.y));
        o.z = pk2(s[4] * inv - bflo(c.z), s[5] * inv - bfhi(c.z)); o.w = pk2(s[6] * inv - bflo(c.w), s[7] * inv - bfhi(c.w));
        *(u32x4*)(P.dn + ((size_t)b * SEQ + t) * DM + chunk * 8) = o;
        if (i < 7) { acc(s, vin[i], (t + W / 2 < SEQ) ? 1.0f : 0.0f); acc(s, vout[i], (t - W / 2 >= 0) ? -1.0f : 0.0f); }
    }
}

struct WmStd { int c0; __device__ __forceinline__ int operator()(int i) const { return wrow_std(c0 + i); } };
__global__ void __launch_bounds__(512) naive_g1(Args a) {
    const Ptrs P = make_ptrs(a); Frame F; F.tid = threadIdx.x; F.lane = F.tid & 63; F.wave = F.tid >> 6; F.vcu = blockIdx.x; F.G = gridDim.x; F.lds = nullptr;
    ctx_kv(F, P);
    const int gw = blockIdx.x * 8 + F.wave, NGW = gridDim.x * 8, lane = F.lane, hi = lane >> 5, r = lane & 31;
    for (int it = gw; it < (MTOK / 32) * (INW / 64); it += NGW) {
        const int ct = it % (INW / 64), rt = it / (INW / 64), row0 = rt * 32, col0 = ct * 64, row = row0 + r;
        f32x16 d0 = {}, d1 = {};
        WmIn wm{col0};
        wave_gemm_acc(P.xn, DM, P.wtin, DM, DM, row0, wm, d0, d1, lane);
        if (col0 < 512) {
#pragma unroll
            for (int i = 0; i < 16; ++i) { P.u[(size_t)row * PW + col0 + dcol(0, i, hi)] = f2bf(d0[i]); P.u[(size_t)row * PW + col0 + dcol(1, i, hi)] = f2bf(d1[i]); }
        } else if (col0 < 1536) {
            const bool isq = col0 < 1024; const int h = ((col0 - 512) & 511) >> 6;
            f32x16 y0, y1, r0, r1;
            head_norm_rope(d0, d1, isq ? P.qg : P.kg, P.tab, row & (SEQ - 1), hi, y0, y1, r0, r1);
#pragma unroll
            for (int i = 0; i < 16; ++i) { const size_t o0 = (size_t)row * NAW + h * 64 + dcol(0, i, hi), o1 = (size_t)row * NAW + h * 64 + dcol(1, i, hi);
                if (isq) { P.qp[o0] = f2bf(0.125f * y0[i]); P.qp[o1] = f2bf(0.125f * y1[i]); P.qr[o0] = f2bf(0.125f * r0[i]); P.qr[o1] = f2bf(0.125f * r1[i]); }
                else { P.kr[kr_index(row >> 13, row & (SEQ - 1), h, dcol(0, i, hi))] = f2bf(r0[i]); P.kr[kr_index(row >> 13, row & (SEQ - 1), h, dcol(1, i, hi))] = f2bf(r1[i]); } }
        } else if (col0 < 2048) {
            const int h = (col0 - 1536) >> 6, b = row >> 13, t = row & (SEQ - 1);
#pragma unroll
            for (int i = 0; i < 16; ++i) { P.vt[vt_index(b, h, dcol(0, i, hi), t)] = f2bf(d0[i]); P.vt[vt_index(b, h, dcol(1, i, hi), t)] = f2bf(d1[i]); }
        } else {
            bf16_t* dst = (col0 < 3072) ? P.sgp : P.sgn; const int cb = (col0 < 3072) ? col0 - 2048 : col0 - 3072;
#pragma unroll
            for (int i = 0; i < 16; ++i) { dst[(size_t)row * DM + cb + dcol(0, i, hi)] = f2bf(sigmoidf_(d0[i])); dst[(size_t)row * DM + cb + dcol(1, i, hi)] = f2bf(sigmoidf_(d1[i])); }
        }
    }
}
__global__ void __launch_bounds__(256) naive_attn(Args a) {
    const Ptrs P = make_ptrs(a);
    for (int i = blockIdx.x * 256 + threadIdx.x; i < MTOK * 64; i += gridDim.x * 256) pool_item(P, i >> 6, i & 63);
    for (int i = blockIdx.x * 256 + threadIdx.x; i < MTOK * NH; i += gridDim.x * 256) {
        const int h = i & 7, row = i >> 3, b = row >> 13, t = row & (SEQ - 1), r = t >> 6, c = t & 63;
        const int r0 = min(max(r - 4, 0), NROWS - 8), c0 = min(max(c - 8, 0), GW - 16);
        float q[64], qp[64], o[64];
#pragma unroll
        for (int d = 0; d < 64; ++d) { q[d] = bf2f(P.qr[(size_t)row * NAW + h * 64 + d]); qp[d] = bf2f(P.qp[(size_t)row * NAW + h * 64 + d]); o[d] = 0.f; }
        float mx = -1e30f, l = 0.f;
        for (int kk = 0; kk < 128 + CTXL; ++kk) {
            float s = 0.f;
            if (kk < 128) { const int kr = r0 + (kk >> 4), kcn = c0 + (kk & 15);
#pragma unroll
                for (int d = 0; d < 64; ++d) s += q[d] * bf2f(P.kr[kr_index(b, kr * 64 + kcn, h, d)]);
                s += P.rpb[(h * 15 + (kr - r + 7)) * 31 + (kcn - c + 15)];
            } else { const int n = kk - 128;
#pragma unroll
                for (int d = 0; d < 64; ++d) s += qp[d] * bf2f(P.kc[kc_index(b, n, h, d)]); }
            const float mn = fmaxf(mx, s), f = __expf(mx - mn), p = __expf(s - mn);
            l = l * f + p;
#pragma unroll
            for (int d = 0; d < 64; ++d) o[d] = o[d] * f + p * bf2f(kk < 128 ? P.vt[vt_index(b, h, d, (r0 + (kk >> 4)) * 64 + c0 + (kk & 15))] : P.vct[vct_index(b, h, d, kk - 128)]);
            mx = mn;
        }
        const float il = 1.0f / l;
#pragma unroll
        for (int d = 0; d < 64; ++d) P.dn[(size_t)row * DM + 512 + h * 64 + d] = f2bf(o[d] * il);
    }
}
__global__ void __launch_bounds__(512) naive_g2(Args a) {
    const Ptrs P = make_ptrs(a); const int lane = threadIdx.x & 63, hi = lane >> 5, r = lane & 31;
    const int gw = blockIdx.x * 8 + (threadIdx.x >> 6), NGW = gridDim.x * 8;
    for (int it = gw; it < (MTOK / 32) * (DM / 64); it += NGW) {
        const int ct = it % (DM / 64), rt = it / (DM / 64), row0 = rt * 32, col0 = ct * 64, row = row0 + r;
        f32x16 d0 = {}, d1 = {}, e0 = {}, e1 = {};
        WmStd wm{col0};
        wave_gemm_acc(P.dn, DM, P.wtbr, DM, 512, row0, wm, d0, d1, lane);
        wave_gemm_acc(P.dn + 512, DM, P.wtbr + 512, DM, 512, row0, wm, e0, e1, lane);
#pragma unroll
        for (int i = 0; i < 16; ++i) { const size_t o0 = (size_t)row * DM + col0 + dcol(0, i, hi), o1 = (size_t)row * DM + col0 + dcol(1, i, hi);
            P.mg[o0] = f2bf(bf2f(P.sgp[o0]) * d0[i] + bf2f(P.sgn[o0]) * e0[i]); P.mg[o1] = f2bf(bf2f(P.sgp[o1]) * d1[i] + bf2f(P.sgn[o1]) * e1[i]); }
    }
}
__global__ void __launch_bounds__(512) naive_g3(Args a) {
    const Ptrs P = make_ptrs(a); const int lane = threadIdx.x & 63, hi = lane >> 5, r = lane & 31;
    const int gw = blockIdx.x * 8 + (threadIdx.x >> 6), NGW = gridDim.x * 8;
    for (int it = gw; it < (MTOK / 32) * 4; it += NGW) {
        const int pn = it & 3, rt = it >> 2, row0 = rt * 32, row = row0 + r, b = row >> 13;
        for (int q = 0; q < 4; ++q) {
            float ss = 0.f;
            const int col0 = pn * 256 + q * 64;
            f32x16 d0 = {}, d1 = {};
            WmStd wm{col0};
            wave_gemm_acc(P.mg, DM, P.wtout, DM, DM, row0, wm, d0, d1, lane);
#pragma unroll
            for (int i = 0; i < 16; ++i)
#pragma unroll
                for (int blk = 0; blk < 2; ++blk) { const int col = col0 + dcol(blk, i, hi); const size_t o = (size_t)row * DM + col;
                    const float xn = P.x[o] + P.mod[b * 6144 + 2048 + col] * (blk ? d1[i] : d0[i]);
                    P.xnb[o] = f2bf(xn); P.xg[o] = f2bf(xn * P.n2g[col] * (1.0f + P.mod[b * 6144 + 4096 + col])); ss += xn * xn; }
            ss += __shfl_xor(ss, 32);
            if (hi == 0) P.rowp[(size_t)row * 16 + pn * 4 + q] = ss;
        }
    }
}
__global__ void __launch_bounds__(512) naive_g4(Args a) {
    const Ptrs P = make_ptrs(a); const int lane = threadIdx.x & 63, hi = lane >> 5, r = lane & 31;
    const int gw = blockIdx.x * 8 + (threadIdx.x >> 6), NGW = gridDim.x * 8;
    for (int it = gw; it < (MTOK / 32) * (FF / 64); it += NGW) {
        const int ct = it % (FF / 64), rt = it / (FF / 64), row0 = rt * 32, col0 = ct * 64, row = row0 + r, b = row >> 13;
        f32x16 d0 = {}, d1 = {};
        WmStd wm{col0};
        wave_gemm_acc(P.xg, DM, P.wt1, DM, DM, row0, wm, d0, d1, lane);
        float sq = 0.f;
#pragma unroll
        for (int q = 0; q < 4; ++q) { const f32x4 rp = *(const f32x4*)(P.rowp + (size_t)row * 16 + 4 * q); sq += (rp.x + rp.y) + (rp.z + rp.w); }
        const float rstd = rsqrtf(sq * (1.0f / DM) + EPS);
#pragma unroll
        for (int i = 0; i < 16; ++i)
#pragma unroll
            for (int blk = 0; blk < 2; ++blk) { const int col = col0 + dcol(blk, i, hi); const float v = fmaxf(rstd * (blk ? d1[i] : d0[i]) + P.bias2[b * FF + col], 0.f); P.h[(size_t)row * FF + col] = f2bf(v * v); }
    }
}
__global__ void __launch_bounds__(512) naive_g5(Args a) {
    const Ptrs P = make_ptrs(a); const int lane = threadIdx.x & 63, hi = lane >> 5, r = lane & 31;
    const int gw = blockIdx.x * 8 + (threadIdx.x >> 6), NGW = gridDim.x * 8;
    for (int it = gw; it < (MTOK / 32) * (DM / 64); it += NGW) {
        const int ct = it % (DM / 64), rt = it / (DM / 64), row0 = rt * 32, col0 = ct * 64, row = row0 + r, b = row >> 13;
        f32x16 d0 = {}, d1 = {};
        WmStd wm{col0};
        wave_gemm_acc(P.h, FF, P.wt2, FF, FF, row0, wm, d0, d1, lane);
#pragma unroll
        for (int i = 0; i < 16; ++i)
#pragma unroll
            for (int blk = 0; blk < 2; ++blk) { const int col = col0 + dcol(blk, i, hi); const size_t o = (size_t)row * DM + col; P.out[o] = bf2f(P.xnb[o]) + P.mod[b * 6144 + 5120 + col] * (blk ? d1[i] : d0[i]); }
    }
}


constexpr size_t TILEB = 256 * 2;
struct SchedG1 {
    const char *xn, *wt; int G, c;
    __device__ __forceinline__ bool next(int i, pg8::Unit& u) const { if (!pg8::static_tile(MTOK / 256, INW / 256, G, c, i, u.pm, u.pn)) return false; u.kind = (u.pn == 6 || u.pn == 7) ? 1 : 0; return true; }
    __device__ __forceinline__ const char* abase(const pg8::Unit& u) const { return u.kind ? wt + (size_t)(256 * u.pn) * (DM * 2) : xn + (size_t)(256 * u.pm) * (DM * 2); }
    __device__ __forceinline__ const char* bbase(const pg8::Unit& u) const { return u.kind ? xn + (size_t)(256 * u.pm) * (DM * 2) : wt + (size_t)(256 * u.pn) * (DM * 2); }
};
struct SchedG2 {
    const char *dn, *wt; int G, c;
    __device__ __forceinline__ bool next(int i, pg8::Unit& u) const { if (!pg8::static_tile(MTOK / 256, DM / 256, G, c, i >> 1, u.pm, u.pn)) return false; u.kind = i & 1; return true; }
    __device__ __forceinline__ const char* abase(const pg8::Unit& u) const { return dn + (size_t)(256 * u.pm) * (DM * 2) + u.kind * 1024; }
    __device__ __forceinline__ const char* bbase(const pg8::Unit& u) const { return wt + (size_t)(256 * u.pn) * (DM * 2) + u.kind * 1024; }
};
struct SchedStd {
    const char *a, *b; int nM, nN, ldb2, G, c;
    __device__ __forceinline__ bool next(int i, pg8::Unit& u) const { if (!pg8::static_tile(nM, nN, G, c, i, u.pm, u.pn)) return false; u.kind = i; return true; }
    __device__ __forceinline__ const char* abase(const pg8::Unit& u) const { return a + (size_t)(256 * u.pm) * ldb2; }
    __device__ __forceinline__ const char* bbase(const pg8::Unit& u) const { return b + (size_t)(256 * u.pn) * ldb2; }
};
typedef f32x4 acc_t[2][2][4][2];
__host__ __device__ __forceinline__ size_t t1k_index(int row, int col) { return ((size_t)((row >> 8) * (DM / 64) + (col >> 6)) * 256 + (row & 255)) * 64 + (col & 63); }
__host__ __device__ __forceinline__ size_t h_index(int row, int col) { return ((size_t)((row >> 8) * (FF / 64) + (col >> 6)) * 256 + (row & 255)) * 64 + (col & 63); }

struct EpiG1 {
    static constexpr bool AFTER_DRAIN = false, MID = false;
    bf16_t *u, *qr, *qp, *kr, *vt, *sgp, *sgn; const float *qg, *kg; const f32x2* tab; int skip;
    __device__ __forceinline__ void operator()(const acc_t& acc, const pg8::Unit& un, int wr, int wc, int fr, int fq) const {
        const int pn = un.pn;
        if (skip == 5) return;
        if (un.kind == 1) {
            const int b = un.pm >> 5, t0 = (un.pm & 31) * 256 + 32 * wc + 4 * fq;
#pragma unroll
            for (int ai = 0; ai < 2; ++ai)
#pragma unroll
                for (int m = 0; m < 4; ++m) { const int ch = 256 * (pn - 6) + 128 * ai + 64 * wr + 16 * m + fr;
#pragma unroll
                    for (int bj = 0; bj < 2; ++bj)
#pragma unroll
                        for (int n = 0; n < 2; ++n) { const f32x4 v = acc[ai][bj][m][n]; u32x2 w; w.x = pk2(v[0], v[1]); w.y = pk2(v[2], v[3]); *(u32x2*)(vt + vt_index(b, ch >> 6, ch & 63, t0 + 128 * bj + 16 * n)) = w; } }
        } else if (pn >= 2 && pn <= 5) {
            const bool isq = pn < 4; const int head = 4 * (pn - (isq ? 2 : 4)) + wc, fh = fq >> 1, fl = fq & 1;
            const float* g = isq ? qg : kg;
            f32x4 gv[2][2];
#pragma unroll
            for (int bj = 0; bj < 2; ++bj)
#pragma unroll
                for (int n = 0; n < 2; ++n) gv[bj][n] = *(const f32x4*)(g + 32 * fh + 16 * bj + 8 * fl + 4 * n);
            const float osc = isq ? 0.125f : 1.0f;
#pragma unroll
            for (int ai = 0; ai < 2; ++ai)
#pragma unroll
                for (int m = 0; m < 4; ++m) {
                    const int row = 256 * un.pm + 128 * ai + 64 * wr + 16 * m + fr, t = row & (SEQ - 1), pos = fh ? (t & 63) : (t >> 6);
                    float ss = 0.f;
#pragma unroll
                    for (int bj = 0; bj < 2; ++bj)
#pragma unroll
                        for (int n = 0; n < 2; ++n) { const f32x4 v = acc[ai][bj][m][n]; ss += (v[0] * v[0] + v[1] * v[1]) + (v[2] * v[2] + v[3] * v[3]); }
                    ss += __shfl_xor(ss, 16); ss += __shfl_xor(ss, 32);
                    const float rstd = rsqrtf(ss * (1.0f / 64.0f) + EPS) * osc;
                    f32x4 y[2][2];
#pragma unroll
                    for (int bj = 0; bj < 2; ++bj)
#pragma unroll
                        for (int n = 0; n < 2; ++n) y[bj][n] = acc[ai][bj][m][n] * rstd * gv[bj][n];
                    const size_t off = (size_t)row * NAW + head * 64 + 32 * fh + 8 * fl;
                    if (isq) {
#pragma unroll
                        for (int bj = 0; bj < 2; ++bj) { u32x4 w; w.x = pk2(y[bj][0][0], y[bj][0][1]); w.y = pk2(y[bj][0][2], y[bj][0][3]); w.z = pk2(y[bj][1][0], y[bj][1][1]); w.w = pk2(y[bj][1][2], y[bj][1][3]); *(u32x4*)(qp + off + 16 * bj) = w; }
                    }
                    f32x4 o1[2], o2[2];
#pragma unroll
                    for (int n = 0; n < 2; ++n) { const f32x4 ca = *(const f32x4*)(tab + pos * 16 + 8 * fl + 4 * n), cb = *(const f32x4*)(tab + pos * 16 + 8 * fl + 4 * n + 2);
                        const f32x4 cs = {ca[0], ca[2], cb[0], cb[2]}, sn = {ca[1], ca[3], cb[1], cb[3]};
                        o1[n] = y[0][n] * cs - y[1][n] * sn; o2[n] = y[0][n] * sn + y[1][n] * cs; }
                    bf16_t* d1p = isq ? qr + off : kr + kr_index(row >> 13, t, head, 32 * fh + 8 * fl); bf16_t* d2p = isq ? qr + off + 16 : kr + kr_index(row >> 13, t, head, 32 * fh + 16 + 8 * fl);
                    { u32x4 w; w.x = pk2(o1[0][0], o1[0][1]); w.y = pk2(o1[0][2], o1[0][3]); w.z = pk2(o1[1][0], o1[1][1]); w.w = pk2(o1[1][2], o1[1][3]); *(u32x4*)d1p = w; }
                    { u32x4 w; w.x = pk2(o2[0][0], o2[0][1]); w.y = pk2(o2[0][2], o2[0][3]); w.z = pk2(o2[1][0], o2[1][1]); w.w = pk2(o2[1][2], o2[1][3]); *(u32x4*)d2p = w; }
                }
        } else {
            bf16_t* dst; int ldd, cb; bool sig;
            if (pn < 2) { dst = u; ldd = PW; cb = 256 * pn; sig = false; } else if (pn < 12) { dst = sgp; ldd = DM; cb = 256 * (pn - 8); sig = true; } else { dst = sgn; ldd = DM; cb = 256 * (pn - 12); sig = true; }
#pragma unroll
            for (int ai = 0; ai < 2; ++ai)
#pragma unroll
                for (int m = 0; m < 4; ++m) { const int row = 256 * un.pm + 128 * ai + 64 * wr + 16 * m + fr;
#pragma unroll
                    for (int bj = 0; bj < 2; ++bj) { f32x4 v0 = acc[ai][bj][m][0], v1 = acc[ai][bj][m][1];
                        if (sig) {
#pragma unroll
                            for (int e = 0; e < 4; ++e) { v0[e] = sigmoidf_(v0[e]); v1[e] = sigmoidf_(v1[e]); } }
                        u32x4 w; w.x = pk2(v0[0], v0[1]); w.y = pk2(v0[2], v0[3]); w.z = pk2(v1[0], v1[1]); w.w = pk2(v1[2], v1[3]);
                        *(u32x4*)(dst + (size_t)row * ldd + cb + 128 * bj + 32 * wc + 8 * fq) = w; } }
        }
    }
};

struct SchedCtx {
    const char *xn, *wt; int id;
    __device__ __forceinline__ bool next(int i, pg8::Unit& u) const { if (i != 0) return false; u.pm = (id >> 2) & 1; u.pn = id & 3; u.kind = id >> 3; return true; }
    __device__ __forceinline__ const char* abase(const pg8::Unit& u) const { return xn + (size_t)(MTOK + 256 * u.pm) * (DM * 2) + u.kind * 512; }
    __device__ __forceinline__ const char* bbase(const pg8::Unit& u) const { return wt + (size_t)(1024 + 256 * u.pn) * (DM * 2) + u.kind * 512; }
};
struct EpiCtx {
    static constexpr bool AFTER_DRAIN = false, MID = false;
    float* zc;
    __device__ __forceinline__ void operator()(const acc_t& acc, const pg8::Unit& un, int wr, int wc, int fr, int fq) const {
        float* base = zc + ((size_t)un.kind * MCTX + 256 * un.pm + 64 * wr + fr) * 1024 + 256 * un.pn + 32 * wc + 4 * fq;
#pragma unroll
        for (int ai = 0; ai < 2; ++ai)
#pragma unroll
            for (int m = 0; m < 4; ++m)
#pragma unroll
                for (int bj = 0; bj < 2; ++bj)
#pragma unroll
                    for (int n = 0; n < 2; ++n) *(f32x4*)(base + (size_t)(128 * ai + 16 * m) * 1024 + 128 * bj + 16 * n) = acc[ai][bj][m][n];
    }
};
__device__ __forceinline__ void ctx_finalize(const Frame& F, const Ptrs& P) {
    const int gw = F.vcu * NWAVES + F.wave, NGW = F.G * NWAVES;
    for (int it = gw; it < MCTX * 4; it += NGW) {
        const int row = it >> 2, t = it & 3, b = row >> 8, nt = row & 255;
        f32x4 v = {0.f, 0.f, 0.f, 0.f};
#pragma unroll
        for (int kq = 0; kq < 4; ++kq) v += *(const f32x4*)(P.zc + ((size_t)kq * MCTX + row) * 1024 + 256 * t + 4 * F.lane);
        if (t < 2) {
            const int bj = F.lane >> 5, wc = (F.lane >> 3) & 3, n = (F.lane >> 2) & 1, fq = F.lane & 3, d0 = 32 * (fq >> 1) + 16 * bj + 8 * (fq & 1) + 4 * n;
            float ss = (v[0] * v[0] + v[1] * v[1]) + (v[2] * v[2] + v[3] * v[3]);
            ss += __shfl_xor(ss, 1); ss += __shfl_xor(ss, 2); ss += __shfl_xor(ss, 4); ss += __shfl_xor(ss, 32);
            const float rstd = rsqrtf(ss * (1.0f / 64.0f) + EPS);
            const f32x4 g = *(const f32x4*)(P.kg + d0), y = v * rstd * g;
            u32x2 w; w.x = pk2(y[0], y[1]); w.y = pk2(y[2], y[3]);
            *(u32x2*)(P.kc + kc_index(b, nt, 4 * t + wc, d0)) = w;
        } else {
            const int ch = 256 * (t - 2) + 4 * F.lane;
#pragma unroll
            for (int j = 0; j < 4; ++j) P.vct[vct_index(b, (ch + j) >> 6, (ch + j) & 63, nt)] = f2bf(v[j]);
        }
    }
}

struct EpiG2 {
    static constexpr bool AFTER_DRAIN = false, MID = true;
    const bf16_t *sgp, *sgn; bf16_t* mg;
    __device__ __forceinline__ void mid(acc_t& acc, const pg8::Unit& un, int wr, int wc, int fr, int fq) const {
        const size_t off0 = (size_t)(256 * un.pm + 64 * wr + fr) * DM + 256 * un.pn + 32 * wc + 8 * fq;
        const bf16_t* pp = sgp + off0; const bf16_t* np = sgn + off0;
#pragma unroll
        for (int ai = 0; ai < 2; ++ai)
#pragma unroll
            for (int m = 0; m < 4; ++m) {
#pragma unroll
                for (int bj = 0; bj < 2; ++bj) { const u32x4 a = __builtin_nontemporal_load((const u32x4*)(pp + 128 * bj)), c = *(const u32x4*)(np + 128 * bj);
                    const f32x4 p0 = {bflo(a.x), bfhi(a.x), bflo(a.y), bfhi(a.y)}, p1 = {bflo(a.z), bfhi(a.z), bflo(a.w), bfhi(a.w)};
                    const f32x4 n0 = {bflo(c.x), bfhi(c.x), bflo(c.y), bfhi(c.y)}, n1 = {bflo(c.z), bfhi(c.z), bflo(c.w), bfhi(c.w)};
#pragma unroll
                    for (int e = 0; e < 4; ++e) { acc[ai][bj][m][0][e] *= p0[e] * __builtin_amdgcn_rcpf(fmaxf(n0[e], 1e-20f)); acc[ai][bj][m][1][e] *= p1[e] * __builtin_amdgcn_rcpf(fmaxf(n1[e], 1e-20f)); } }
                pp += (m == 3 ? 80 : 16) * DM; np += (m == 3 ? 80 : 16) * DM; asm volatile("" : "+v"(pp), "+v"(np) :: "memory"); }
    }
    __device__ __forceinline__ void operator()(const acc_t& acc, const pg8::Unit& un, int wr, int wc, int fr, int fq) const {
        const size_t off0 = (size_t)(256 * un.pm + 64 * wr + fr) * DM + 256 * un.pn + 32 * wc + 8 * fq;
        const bf16_t* np = sgn + off0; const int row0 = 256 * un.pm + 64 * wr + fr, col0 = 256 * un.pn + 32 * wc + 8 * fq;
#pragma unroll
        for (int ai = 0; ai < 2; ++ai)
#pragma unroll
            for (int m = 0; m < 4; ++m) {
#pragma unroll
                for (int bj = 0; bj < 2; ++bj) { const u32x4 c = *(const u32x4*)(np + 128 * bj);
                    const f32x4 n0 = {bflo(c.x), bfhi(c.x), bflo(c.y), bfhi(c.y)}, n1 = {bflo(c.z), bfhi(c.z), bflo(c.w), bfhi(c.w)};
                    f32x4 v0, v1;
#pragma unroll
                    for (int e = 0; e < 4; ++e) { v0[e] = acc[ai][bj][m][0][e] * fmaxf(n0[e], 1e-20f); v1[e] = acc[ai][bj][m][1][e] * fmaxf(n1[e], 1e-20f); }
                    u32x4 w; w.x = pk2(v0[0], v0[1]); w.y = pk2(v0[2], v0[3]); w.z = pk2(v1[0], v1[1]); w.w = pk2(v1[2], v1[3]); *(u32x4*)(mg + t1k_index(row0 + 128 * ai + 16 * m, col0 + 128 * bj)) = w; }
                np += (m == 3 ? 80 : 16) * DM; asm volatile("" : "+v"(np) :: "memory"); }
    }
};

struct EpiG3 {
    static constexpr bool AFTER_DRAIN = false, MID = false;
    const float *x, *mod, *n2g; bf16_t* xnb; float* rowp; bf16_t* xg;
    __device__ __forceinline__ void operator()(const acc_t& acc, const pg8::Unit& un, int wr, int wc, int fr, int fq) const {
        const int b = un.pm >> 5, colb = 256 * un.pn + 32 * wc + 8 * fq;
        f32x4 g1v[2][2], gm[2][2];
#pragma unroll
        for (int bj = 0; bj < 2; ++bj)
#pragma unroll
            for (int n = 0; n < 2; ++n) { const int col = colb + 128 * bj + 4 * n; g1v[bj][n] = *(const f32x4*)(mod + b * 6144 + 2048 + col);
                gm[bj][n] = *(const f32x4*)(n2g + col) * (*(const f32x4*)(mod + b * 6144 + 4096 + col) + 1.0f); }
        const size_t off0 = (size_t)(256 * un.pm + 64 * wr + fr) * DM + colb;
#define XROW(g_) ((size_t)(128 * ((g_) >> 2) + 16 * ((g_) & 3)) * DM)
        f32x4 xp[3][2][2];
#pragma unroll
        for (int g = 0; g < 3; ++g)
#pragma unroll
            for (int bj = 0; bj < 2; ++bj) { xp[g][bj][0] = __builtin_nontemporal_load((const f32x4*)(x + off0 + XROW(g) + 128 * bj)); xp[g][bj][1] = __builtin_nontemporal_load((const f32x4*)(x + off0 + XROW(g) + 128 * bj + 4)); }
#pragma unroll
        for (int g = 0; g < 8; ++g) { const int ai = g >> 2, m = g & 3, row = 256 * un.pm + 128 * ai + 64 * wr + 16 * m + fr; float ss = 0.f;
                f32x4 v[2][2];
#pragma unroll
                for (int bj = 0; bj < 2; ++bj) { v[bj][0] = xp[g % 3][bj][0] + g1v[bj][0] * acc[ai][bj][m][0]; v[bj][1] = xp[g % 3][bj][1] + g1v[bj][1] * acc[ai][bj][m][1]; }
                if (g + 3 < 8) {
#pragma unroll
                    for (int bj = 0; bj < 2; ++bj) { xp[g % 3][bj][0] = __builtin_nontemporal_load((const f32x4*)(x + off0 + XROW(g + 3) + 128 * bj)); xp[g % 3][bj][1] = __builtin_nontemporal_load((const f32x4*)(x + off0 + XROW(g + 3) + 128 * bj + 4)); } }
#pragma unroll
                for (int bj = 0; bj < 2; ++bj) { const size_t off = (size_t)row * DM + colb + 128 * bj; const f32x4 v0 = v[bj][0], v1 = v[bj][1];
                    { u32x4 wn; wn.x = pk2(v0[0], v0[1]); wn.y = pk2(v0[2], v0[3]); wn.z = pk2(v1[0], v1[1]); wn.w = pk2(v1[2], v1[3]); *(u32x4*)(xnb + off) = wn; }
                    ss += (v0[0] * v0[0] + v0[1] * v0[1]) + (v0[2] * v0[2] + v0[3] * v0[3]) + (v1[0] * v1[0] + v1[1] * v1[1]) + (v1[2] * v1[2] + v1[3] * v1[3]);
                    const f32x4 h0 = v0 * gm[bj][0], h1 = v1 * gm[bj][1];
                    u32x4 w; w.x = pk2(h0[0], h0[1]); w.y = pk2(h0[2], h0[3]); w.z = pk2(h1[0], h1[1]); w.w = pk2(h1[2], h1[3]); *(u32x4*)(xg + t1k_index(row, colb + 128 * bj)) = w; }
                ss += __shfl_xor(ss, 16); ss += __shfl_xor(ss, 32);
                if (fq == 0) rowp[(size_t)row * 16 + un.pn * 4 + wc] = ss; }
#undef XROW
    }
};

constexpr int RSTD_OFF = MISC_OFF + 128;
struct EpiG4 {
    static constexpr bool AFTER_DRAIN = false, MID = false;
    const float* bias2; bf16_t* h; const LAS float* rs;
    __device__ __forceinline__ void operator()(const acc_t& acc, const pg8::Unit& un, int wr, int wc, int fr, int fq) const {
        const int b = un.pm >> 5, colb = 256 * un.pn + 32 * wc + 8 * fq;
        f32x4 bv[2][2];
#pragma unroll
        for (int bj = 0; bj < 2; ++bj)
#pragma unroll
            for (int n = 0; n < 2; ++n) bv[bj][n] = *(const f32x4*)(bias2 + b * FF + colb + 128 * bj + 4 * n);
#pragma unroll
        for (int ai = 0; ai < 2; ++ai)
#pragma unroll
            for (int m = 0; m < 4; ++m) { const int rt = 128 * ai + 64 * wr + 16 * m + fr, row = 256 * un.pm + rt; const float rstd = rs[un.kind * 256 + rt];
#pragma unroll
                for (int bj = 0; bj < 2; ++bj) { f32x4 v0 = acc[ai][bj][m][0] * rstd + bv[bj][0], v1 = acc[ai][bj][m][1] * rstd + bv[bj][1];
#pragma unroll
                    for (int e = 0; e < 4; ++e) { const float a0 = fmaxf(v0[e], 0.f), a1 = fmaxf(v1[e], 0.f); v0[e] = a0 * a0; v1[e] = a1 * a1; }
                    u32x4 w; w.x = pk2(v0[0], v0[1]); w.y = pk2(v0[2], v0[3]); w.z = pk2(v1[0], v1[1]); w.w = pk2(v1[2], v1[3]);
                    *(u32x4*)(h + h_index(row, colb + 128 * bj)) = w; } }
    }
};

struct EpiG5 {
    static constexpr bool AFTER_DRAIN = false, MID = false;
    const float* mod; const bf16_t* xnb; float* out;
    __device__ __forceinline__ void operator()(const acc_t& acc, const pg8::Unit& un, int wr, int wc, int fr, int fq) const {
        const int b = un.pm >> 5, colb = 256 * un.pn + 32 * wc + 8 * fq;
        f32x4 g2v[2][2];
#pragma unroll
        for (int bj = 0; bj < 2; ++bj)
#pragma unroll
            for (int n = 0; n < 2; ++n) g2v[bj][n] = *(const f32x4*)(mod + b * 6144 + 5120 + colb + 128 * bj + 4 * n);
        const size_t off0 = (size_t)(256 * un.pm + 64 * wr + fr) * DM + colb;
        u32x4 xp[8][2];
#pragma unroll
        for (int g = 0; g < 8; ++g)
#pragma unroll
            for (int bj = 0; bj < 2; ++bj) xp[g][bj] = __builtin_nontemporal_load((const u32x4*)(xnb + off0 + (size_t)(128 * (g >> 2) + 16 * (g & 3)) * DM + 128 * bj));
#pragma unroll
        for (int ai = 0; ai < 2; ++ai)
#pragma unroll
            for (int m = 0; m < 4; ++m) {
#pragma unroll
                for (int bj = 0; bj < 2; ++bj) { const u32x4 xw = xp[ai * 4 + m][bj];
                    const f32x4 x0 = {bflo(xw.x), bfhi(xw.x), bflo(xw.y), bfhi(xw.y)}, x1 = {bflo(xw.z), bfhi(xw.z), bflo(xw.w), bfhi(xw.w)};
                    const f32x4 v0 = x0 + g2v[bj][0] * acc[ai][bj][m][0], v1 = x1 + g2v[bj][1] * acc[ai][bj][m][1];
                    float* o = out + off0 + (size_t)(128 * ai + 16 * m) * DM + 128 * bj; __builtin_nontemporal_store(v0, (f32x4*)o); __builtin_nontemporal_store(v1, (f32x4*)(o + 4)); } }
    }
};

#define MFMA16(a, b, c) __builtin_amdgcn_mfma_f32_16x16x32_bf16((a), (b), (c), 0, 0, 0)
constexpr int RPB_LD = 56;
#define SB() __builtin_amdgcn_sched_barrier(0)
struct AttnRsrc { __amdgpu_buffer_rsrc_t qr, qp; };
constexpr int ATT_BUF = 65536, ATT_NSTAGE = 10;
__device__ __forceinline__ void attn_dma(const Frame& F, const Ptrs& P, LAS unsigned char* buf, int b, int R0, int h, int kind) {
    unsigned lo = (unsigned)F.lane * 16u; asm volatile("" : "+v"(lo));
    if (kind < 4) {
#pragma unroll
        for (int i = 0; i < 6; ++i) { const int p = F.wave * 6 + i, ten = p / 24, row = min(R0 + 3 * kind + (p % 24) / 8, NROWS - 1), pc = p & 7;
            const char* ub = (const char*)((ten ? P.vt : P.kr) + (size_t)((b * NROWS + row) * NH + h) * 4096 + pc * 512);
            __builtin_amdgcn_global_load_lds((const unsigned*)(ub + lo), (LAS unsigned*)(buf + p * 1024), 16, 0, 0); }
    } else {
#pragma unroll
        for (int i = 0; i < 8; ++i) { const int p = F.wave * 8 + i;
            const char* ub = (const char*)(((p >> 5) ? P.vct : P.kc) + (size_t)(b * NH + h) * 16384 + (p & 31) * 512);
            __builtin_amdgcn_global_load_lds((const unsigned*)(ub + lo), (LAS unsigned*)(buf + p * 1024), 16, 0, 0); }
    }
}
__device__ __forceinline__ void attn_phase(const Frame& F, const Ptrs& P, int variant) {
    AttnRsrc R;
    R.qr = __builtin_amdgcn_make_buffer_rsrc((void*)P.qr, (short)0, MTOK * NAW * 2, 0x00020000); R.qp = __builtin_amdgcn_make_buffer_rsrc((void*)P.qp, (short)0, MTOK * NAW * 2, 0x00020000);
    LAS float* rl = (LAS float*)(F.lds + RSTD_OFF);
    for (int i = F.tid; i < NH * 15 * RPB_LD; i += 512) { const int hr = i / RPB_LD, cc = i % RPB_LD - 8; rl[i] = (cc >= 0 && cc < 31) ? P.rpb[hr * 31 + cc] : 0.f; }
    __syncthreads();
    const int lane = F.lane, qi = lane & 15, fq = lane >> 4, rs = F.wave >> 2, jb = F.wave & 3;
    const float LOG2E = 1.4426950408889634f;
    const f32x4 zero = {0.f, 0.f, 0.f, 0.f};
#define LDF(rs_, so, vo) __builtin_bit_cast(bf16x8, __builtin_amdgcn_raw_buffer_load_b128((rs_), (int)(vo), (int)(so), 2))
    for (int item = F.vcu; item < NB * (NROWS / 4) * 4; item += F.G) {
        const int b = item >> 7, rqd = (item >> 2) & 31, hp = item & 3, r = 4 * rqd;
        if (variant != 2) {
            const int g = F.wave & 3, t0 = (r + hp) * 64 + (F.wave >> 2) * 32 + (lane >> 4) * 8, ch = 16 * g + (lane & 15);
            if (g == 0) pool_seg8<2>(P, b, t0, ch); else if (g == 1) pool_seg8<4>(P, b, t0, ch); else if (g == 2) pool_seg8<8>(P, b, t0, ch); else pool_seg8<16>(P, b, t0, ch);
        }
        if (variant == 1) continue;
        const int R0 = min(max(r - 4, 0), NROWS - 8), rq0 = r + 2 * rs;
        const int w00 = min(max(rq0 - 4, 0), NROWS - 8) - R0, w01 = min(max(rq0 - 3, 0), NROWS - 8) - R0;
        const int c = 16 * jb + qi, kc0 = min(max(16 * jb - 8, 0), 32), c0 = min(max(c - 8, 0), GW - 16), kq0 = kc0 + 8 * fq - c0;
        const unsigned qoff = (unsigned)(qi * NAW + 8 * fq) * 2u, ooff = (unsigned)(qi * DM + 4 * fq) * 2u;
        const int eq0 = (kc0 >> 3) + (qi >> 2);
        const unsigned kl = (unsigned)((fq * 4 + (eq0 >> 2)) * 256 + ((qi & 3) * 4 + (eq0 & 3)) * 16);
        const unsigned vl = (unsigned)(((kc0 >> 3) + fq) * 1024 + qi * 16);
        const unsigned cl = (unsigned)lane * 16u;
        bf16x8 qr0[2], qr1[2], qp0[2], qp1[2]; float m[2] = {-INFINITY, -INFINITY}, l[2] = {0.f, 0.f}; f32x4 o[2][4] = {{zero, zero, zero, zero}, {zero, zero, zero, zero}};
#pragma unroll
        for (int qb = 0; qb < 2; ++qb) { const unsigned qS = (unsigned)(((b * SEQ + (rq0 + qb) * 64 + 16 * jb) * NAW + (2 * hp) * 64) * 2);
          qr0[qb] = LDF(R.qr, qS, qoff); qr1[qb] = LDF(R.qr, qS + 64u, qoff); qp0[qb] = LDF(R.qp, qS, qoff); qp1[qb] = LDF(R.qp, qS + 64u, qoff); }
        attn_dma(F, P, F.lds, b, R0, 2 * hp, 0);
#define LB(p) (*(const LAS bf16x8*)(p))
#define STAGE_SOFTMAX(NC, SC, PA, M_, L_, O_) do { \
            float cm_ = -INFINITY; \
            _Pragma("unroll") for (int c_ = 0; c_ < NC; ++c_) _Pragma("unroll") for (int e_ = 0; e_ < 8; ++e_) cm_ = fmaxf(cm_, SC[c_][e_]); \
            cm_ = fmaxf(cm_, __shfl_xor(cm_, 16)); cm_ = fmaxf(cm_, __shfl_xor(cm_, 32)); \
            const float mn_ = fmaxf(M_, cm_), al_ = __builtin_amdgcn_exp2f((M_ - mn_) * LOG2E), ml_ = mn_ * LOG2E; M_ = mn_; \
            float ps_ = 0.f; \
            _Pragma("unroll") for (int c_ = 0; c_ < NC; ++c_) { \
                _Pragma("unroll") for (int e_ = 0; e_ < 8; ++e_) { SC[c_][e_] = __builtin_amdgcn_exp2f(SC[c_][e_] * LOG2E - ml_); ps_ += SC[c_][e_]; } \
                u32x4 pw_; pw_.x = pk2(SC[c_][0], SC[c_][1]); pw_.y = pk2(SC[c_][2], SC[c_][3]); pw_.z = pk2(SC[c_][4], SC[c_][5]); pw_.w = pk2(SC[c_][6], SC[c_][7]); PA[c_] = __builtin_bit_cast(bf16x8, pw_); } \
            L_ = L_ * al_ + ps_; \
            _Pragma("unroll") for (int db_ = 0; db_ < 4; ++db_) O_[db_] = O_[db_] * al_; } while (0)
#pragma nounroll
        for (int hi = 0; hi < 2; ++hi) {
            const int h = 2 * hp + hi;
#pragma nounroll
            for (int kind = 0; kind < 4; ++kind) {
                const int t = 5 * hi + kind;
                LAS unsigned char* buf = F.lds + (t & 1) * ATT_BUF;
                __syncthreads();
                attn_dma(F, P, F.lds + ((t + 1) & 1) * ATT_BUF, b, R0, h, kind + 1);
                float sc0[3][8], sc1[3][8]; bf16x8 pa0[3], pa1[3];
                const int u0 = 3 * kind;
                const bool any0 = (u0 + 2 >= w00) && (u0 < w00 + 8), any1 = (u0 + 2 >= w01) && (u0 < w01 + 8);
#pragma unroll
                for (int j = 0; j < 3; ++j) { const int wrA = u0 + j - w00, wrB = u0 + j - w01;
                    const bool inA = wrA >= 0 && wrA < 8, inB = wrB >= 0 && wrB < 8;
                    if (inA || inB) {
                        const LAS unsigned char* kb = buf + j * 8192 + kl;
                        const bf16x8 k00 = LB(kb), k01 = LB(kb + 4096), k10 = LB(kb + 512), k11 = LB(kb + 4096 + 512);
                        if (inA) {
                            const LAS float* bp = rl + h * 15 * RPB_LD + (R0 + w00 - rq0 + 7 + wrA) * RPB_LD + (kc0 + 8 * fq - c + 23);
                            float bs[8];
#pragma unroll
                            for (int e = 0; e < 8; ++e) bs[e] = bp[e];
                            f32x4 s0 = MFMA16(k00, qr0[0], zero); s0 = MFMA16(k01, qr1[0], s0);
                            f32x4 s1 = MFMA16(k10, qr0[0], zero); s1 = MFMA16(k11, qr1[0], s1);
#pragma unroll
                            for (int e = 0; e < 8; ++e) { const bool valid = (unsigned)(kq0 + e) < 16u; sc0[j][e] = valid ? (e < 4 ? s0[e & 3] : s1[e & 3]) + bs[e] : -INFINITY; }
                        } else {
#pragma unroll
                            for (int e = 0; e < 8; ++e) sc0[j][e] = -INFINITY; }
                        if (inB) {
                            const LAS float* bp = rl + h * 15 * RPB_LD + (R0 + w01 - (rq0 + 1) + 7 + wrB) * RPB_LD + (kc0 + 8 * fq - c + 23);
                            float bs[8];
#pragma unroll
                            for (int e = 0; e < 8; ++e) bs[e] = bp[e];
                            f32x4 s0 = MFMA16(k00, qr0[1], zero); s0 = MFMA16(k01, qr1[1], s0);
                            f32x4 s1 = MFMA16(k10, qr0[1], zero); s1 = MFMA16(k11, qr1[1], s1);
#pragma unroll
                            for (int e = 0; e < 8; ++e) { const bool valid = (unsigned)(kq0 + e) < 16u; sc1[j][e] = valid ? (e < 4 ? s0[e & 3] : s1[e & 3]) + bs[e] : -INFINITY; }
                        } else {
#pragma unroll
                            for (int e = 0; e < 8; ++e) sc1[j][e] = -INFINITY; }
                    } else {
#pragma unroll
                        for (int e = 0; e < 8; ++e) { sc0[j][e] = -INFINITY; sc1[j][e] = -INFINITY; } }
                    SB(); }
                if (any0) STAGE_SOFTMAX(3, sc0, pa0, m[0], l[0], o[0]);
                if (any1) STAGE_SOFTMAX(3, sc1, pa1, m[1], l[1], o[1]);
#pragma unroll
                for (int j = 0; j < 3; ++j) { const int wrA = u0 + j - w00, wrB = u0 + j - w01;
                    const bool inA = wrA >= 0 && wrA < 8, inB = wrB >= 0 && wrB < 8;
                    if (inA || inB) { const LAS unsigned char* vb = buf + 24576 + j * 8192 + vl;
#pragma unroll
                        for (int db = 0; db < 4; ++db) { const bf16x8 vf = LB(vb + db * 256);
                            if (inA) o[0][db] = MFMA16(vf, pa0[j], o[0][db]);
                            if (inB) o[1][db] = MFMA16(vf, pa1[j], o[1][db]); } }
                    SB(); }
            }
            {
                const int t = 5 * hi + 4;
                LAS unsigned char* buf = F.lds + (t & 1) * ATT_BUF;
                __syncthreads();
                if (hi == 0) attn_dma(F, P, F.lds + ((t + 1) & 1) * ATT_BUF, b, R0, h + 1, 0);
#pragma unroll
                for (int gs = 0; gs < 4; ++gs) {
                    float sc0[2][8], sc1[2][8]; bf16x8 pa0[2], pa1[2];
#pragma unroll
                    for (int g2 = 0; g2 < 2; ++g2) { const LAS unsigned char* kb = buf + (2 * gs + g2) * 4096 + cl;
                        const bf16x8 k0 = LB(kb), k1 = LB(kb + 1024), k2 = LB(kb + 2048), k3 = LB(kb + 3072);
                        f32x4 s0 = MFMA16(k0, qp0[0], zero); s0 = MFMA16(k1, qp1[0], s0);
                        f32x4 s1 = MFMA16(k2, qp0[0], zero); s1 = MFMA16(k3, qp1[0], s1);
#pragma unroll
                        for (int e = 0; e < 8; ++e) sc0[g2][e] = (e < 4 ? s0[e & 3] : s1[e & 3]);
                        s0 = MFMA16(k0, qp0[1], zero); s0 = MFMA16(k1, qp1[1], s0);
                        s1 = MFMA16(k2, qp0[1], zero); s1 = MFMA16(k3, qp1[1], s1);
#pragma unroll
                        for (int e = 0; e < 8; ++e) sc1[g2][e] = (e < 4 ? s0[e & 3] : s1[e & 3]);
                        SB(); }
                    STAGE_SOFTMAX(2, sc0, pa0, m[0], l[0], o[0]);
                    STAGE_SOFTMAX(2, sc1, pa1, m[1], l[1], o[1]);
                    SB();
#pragma unroll
                    for (int g2 = 0; g2 < 2; ++g2) { const LAS unsigned char* vb = buf + 32768 + (2 * gs + g2) * 4096 + cl;
#pragma unroll
                        for (int db = 0; db < 4; ++db) { const bf16x8 vf = LB(vb + db * 1024);
                            o[0][db] = MFMA16(vf, pa0[g2], o[0][db]); o[1][db] = MFMA16(vf, pa1[g2], o[1][db]); }
                        SB(); }
                }
#pragma unroll
                for (int qb = 0; qb < 2; ++qb) {
                    float lt = l[qb]; lt += __shfl_xor(lt, 16); lt += __shfl_xor(lt, 32);
                    const float il = 1.0f / lt;
                    char* oU = (char*)((variant >= 5 ? P.xn : P.dn) + ((size_t)b * SEQ + (rq0 + qb) * 64 + 16 * jb) * DM + 512 + h * 64);
#pragma unroll
                    for (int db = 0; db < 4; ++db) { const f32x4 ov = o[qb][db] * il; u32x2 w; w.x = pk2(ov[0], ov[1]); w.y = pk2(ov[2], ov[3]); *(u32x2*)(oU + 32 * db + ooff) = w; o[qb][db] = zero; }
                    m[qb] = -INFINITY; l[qb] = 0.f;
                    { const unsigned qS = (unsigned)(((b * SEQ + (rq0 + qb) * 64 + 16 * jb) * NAW + (2 * hp + 1) * 64) * 2);
                      qr0[qb] = LDF(R.qr, qS, qoff); qr1[qb] = LDF(R.qr, qS + 64u, qoff); qp0[qb] = LDF(R.qp, qS, qoff); qp1[qb] = LDF(R.qp, qS + 64u, qoff); }
                }
            }
        }
        __syncthreads();
#undef STAGE_SOFTMAX
#undef LB
    }
#undef LDF
}

__global__ void __launch_bounds__(NWAVES * 64, 2) mk_fwd(Args args) {
    extern __shared__ __attribute__((aligned(16))) unsigned char lds_raw[];
    Frame F; F.lds = (LAS unsigned char*)lds_raw;
    volatile LAS unsigned* MISC = (volatile LAS unsigned*)(F.lds + MISC_OFF);
    F.tid = threadIdx.x; F.lane = F.tid & 63; F.wave = __builtin_amdgcn_readfirstlane(F.tid >> 6);
    F.G = gridDim.x; { const int bx = blockIdx.x; F.vcu = (F.G % 8 == 0) ? (bx % 8) * (F.G / 8) + bx / 8 : bx; }
    const Ptrs P = make_ptrs(args);
    for (int u = F.tid; u < (LDS_BYTES - LDSCTL_OFF) / 4; u += NWAVES * 64) ((LAS unsigned*)(F.lds + LDSCTL_OFF))[u] = 0u;
    __syncthreads();
    XcdBarrier bar; bar.bar = (unsigned*)(P.ws + WS_CTL) + CW_BAR + args.li * XCD_BAR_WORDS; bar.x = 0; bar.st = nullptr;
#if ONE_LAUNCH
    bar = xcd_barrier_post((unsigned*)(P.ws + WS_CTL) + CW_BAR + args.li * XCD_BAR_WORDS, MISC + 8);
#define GRID_BAR() xcd_barrier(bar)
#define SHADOW_BAR(k, work) do { if (BOTH(k)) xcd_barrier_shadow(bar, [&]() { work; }); else { __syncthreads(); if (threadIdx.x >= 64) { work; } __syncthreads(); } } while (0)
#else
#define GRID_BAR() do { } while (0)
#define SHADOW_BAR(k, work) do { __syncthreads(); if (threadIdx.x >= 64) { work; } __syncthreads(); } while (0)
#endif
    const int lo = args.ph_lo, hi = args.ph_hi;
#ifndef PH_MASK
#define PH_MASK 0xFF
#endif
#define IN(k) (((PH_MASK >> (k)) & 1) && lo <= (k) && (k) < hi)
#define BOTH(k) (IN(k) && IN((k) + 1))
    if (IN(0)) { phase0(F, P);   }
    if (IN(1)) {
        phase1(F, P);
        if (F.G > 32 && F.vcu < 32) {
            SchedCtx S{(const char*)P.xn, (const char*)P.wtin, F.vcu};
            EpiCtx E{P.zc};
            pg8::gemm_phase<EpiCtx, SchedCtx, true, true>(F.lds, pg8::Gemm{DM, 256}, S, E);
        }
        SHADOW_BAR(1, late_tiles(F, P, 0, 1792, 7));
    }
    if (IN(2)) {
        if (F.G <= 32) ctx_kv(F, P); else ctx_finalize(F, P);
        SchedG1 S{(const char*)P.xn, (const char*)P.wtin, F.G, (int)blockIdx.x};
        EpiG1 E{P.u, P.qr, P.qp, P.kr, P.vt, P.sgp, P.sgn, P.qg, P.kg, P.tab, args.pad};
        pg8::gemm_phase<EpiG1, SchedG1, true, true>(F.lds, pg8::Gemm{DM, DM}, S, E);
        SHADOW_BAR(2, (late_tiles(F, P, 1792, 512, 2), fold_items(F, P)));
    }
    if (IN(3)) {
        attn_phase(F, P, args.pad);
        SHADOW_BAR(3, late_tiles(F, P, 2304, 1536, 6));
    }
    if (IN(4)) {
        SchedStd S{(const char*)P.dn, (const char*)P.wtbr, MTOK / 256, DM / 256, DM * 2, F.G, (int)blockIdx.x};
        EpiG2 E{P.sgp, P.sgn, P.mg};
        pg8::gemm_phase<EpiG2, SchedStd, true, true>(F.lds, pg8::Gemm{DM, DM}, S, E);
        SHADOW_BAR(4, bias2_items(F, P, F.vcu * 7 + F.wave - 1, F.G * 7));
    }
    if (IN(5)) {
        SchedStd S{(const char*)P.mg, (const char*)P.wtout, MTOK / 256, DM / 256, DM * 2, F.G, (int)blockIdx.x};
        EpiG3 E{P.x, P.mod, P.n2g, P.xnb, P.rowp, P.xg};
        pg8::gemm_phase<EpiG3, SchedStd, true, true, true>(F.lds, pg8::Gemm{DM, DM}, S, E);
        SHADOW_BAR(5, late_tiles(F, P, 3840, 1024, 4));
    }
    if (IN(6)) {
        SchedStd S{(const char*)P.xg, (const char*)P.wt1, MTOK / 256, FF / 256, DM * 2, F.G, (int)blockIdx.x};
        LAS float* rs = (LAS float*)(F.lds + RSTD_OFF);
        { pg8::Unit un;
          for (int i = 0; i < 12 && S.next(i, un); ++i)
              for (int rt = F.tid; rt < 256; rt += NWAVES * 64) { const float* rp = P.rowp + (size_t)(256 * un.pm + rt) * 16; float sq = 0.f;
#pragma unroll
                  for (int q = 0; q < 4; ++q) { const f32x4 v = *(const f32x4*)(rp + 4 * q); sq += (v.x + v.y) + (v.z + v.w); }
                  rs[i * 256 + rt] = rsqrtf(sq * (1.0f / DM) + EPS); }
          __syncthreads(); }
        EpiG4 E{P.bias2, P.h, rs};
        pg8::gemm_phase<EpiG4, SchedStd, true, true, true>(F.lds, pg8::Gemm{DM, DM}, S, E);
        if (BOTH(6)) GRID_BAR();
    }
    if (IN(7)) {
        SchedStd S{(const char*)P.h, (const char*)P.wt2, MTOK / 256, DM / 256, FF * 2, F.G, (int)blockIdx.x};
        EpiG5 E{P.mod, P.xnb, P.out};
        pg8::gemm_phase<EpiG5, SchedStd, true, true, true>(F.lds, pg8::Gemm{FF, FF}, S, E);
    }
#undef IN
#undef BOTH
}

extern "C" void kernel_launch(void* const* d_in, const int* in_sizes, int n_in, void* d_out, int out_size, void* d_ws, size_t ws_size, hipStream_t stream) {
    static int grid = 0;
    if (grid == 0) {
        if (n_in != 19 || in_sizes[0] != MTOK * DM || out_size != MTOK * DM || ws_size < WS_END) { fprintf(stderr, "kernel_launch: unexpected problem shape / workspace (%d inputs, ws %zu)\n", n_in, ws_size); grid = -1; return; }
        int dev = 0, cus = 0, per_cu = 0;
        if (hipGetDevice(&dev) != hipSuccess || hipDeviceGetAttribute(&cus, hipDeviceAttributeMultiprocessorCount, dev) != hipSuccess) { grid = -1; return; }
        if (hipFuncSetAttribute((const void*)mk_fwd, hipFuncAttributeMaxDynamicSharedMemorySize, LDS_BYTES) != hipSuccess) { fprintf(stderr, "kernel_launch: hipFuncSetAttribute failed\n"); grid = -1; return; }
        if (hipOccupancyMaxActiveBlocksPerMultiprocessor(&per_cu, (const void*)mk_fwd, NWAVES * 64, LDS_BYTES) != hipSuccess || per_cu < 1) { fprintf(stderr, "kernel_launch: occupancy query reports %d workgroups per CU\n", per_cu); (void)hipGetLastError(); grid = -1; return; }
        grid = cus;
    }
    if (grid < 0) return;
    (void)hipMemsetAsync((char*)d_ws + WS_CTL, 0, CTL_ZERO_BYTES, stream);
    Args a{};
    for (int i = 0; i < 19; ++i) a.in[i] = (const float*)d_in[i];
    a.out = (float*)d_out; a.ws = (unsigned char*)d_ws;
#if ONE_LAUNCH
#if DUP_PHASE >= 0
#if DUP_MODE == 2
    a.ph_lo = 0; a.ph_hi = NPH; a.li = 0;
#else
    a.ph_lo = 0; a.ph_hi = DUP_PHASE + 1; a.li = 0;
#endif
    hipLaunchKernelGGL(mk_fwd, dim3(grid), dim3(NWAVES * 64), LDS_BYTES, stream, a);
    a.ph_lo = DUP_PHASE; a.ph_hi = NPH; a.li = 1; a.pad = DUP_VARIANT;
    hipLaunchKernelGGL(mk_fwd, dim3(grid), dim3(NWAVES * 64), LDS_BYTES, stream, a);
#else
    a.ph_lo = 0; a.ph_hi = NPH;
    hipLaunchKernelGGL(mk_fwd, dim3(grid), dim3(NWAVES * 64), LDS_BYTES, stream, a);
#endif
#else
    for (int ph = 0; ph < NPH; ++ph) {
        a.ph_lo = ph; a.ph_hi = ph + 1;
        if ((NAIVE_MASK >> ph) & 1) {
            switch (ph) {
                case 2: hipLaunchKernelGGL(naive_g1, dim3(1024), dim3(512), 0, stream, a); break;
                case 3: hipLaunchKernelGGL(naive_attn, dim3(2048), dim3(256), 0, stream, a); break;
                case 4: hipLaunchKernelGGL(naive_g2, dim3(1024), dim3(512), 0, stream, a); break;
                case 5: hipLaunchKernelGGL(naive_g3, dim3(1024), dim3(512), 0, stream, a); break;
                case 6: hipLaunchKernelGGL(naive_g4, dim3(1024), dim3(512), 0, stream, a); break;
                case 7: hipLaunchKernelGGL(naive_g5, dim3(1024), dim3(512), 0, stream, a); break;
                default: break;
            }
        } else {
            hipLaunchKernelGGL(mk_fwd, dim3(grid), dim3(NWAVES * 64), LDS_BYTES, stream, a);
            if (ph == DUP_PHASE) hipLaunchKernelGGL(mk_fwd, dim3(grid), dim3(NWAVES * 64), LDS_BYTES, stream, a);
        }
    }
#endif
}
```

```cpp
#include <hip/hip_runtime.h>
#include <cstdio>
#include <cstdint>

#ifndef ONE_LAUNCH
#define ONE_LAUNCH 1
#endif
#ifndef DUP_PHASE
#define DUP_PHASE -1
#endif
#ifndef DUP_MODE
#define DUP_MODE 1
#endif
#ifndef DUP_VARIANT
#define DUP_VARIANT 0
#endif
#ifndef NAIVE_MASK
#define NAIVE_MASK 0x00
#endif

#define GAS __attribute__((address_space(1)))
#define LAS __attribute__((address_space(3)))
typedef unsigned short bf16_t;
typedef short bf16x8 __attribute__((ext_vector_type(8)));
typedef float f32x2 __attribute__((ext_vector_type(2)));
typedef float f32x4 __attribute__((ext_vector_type(4)));
typedef float f32x16 __attribute__((ext_vector_type(16)));
typedef unsigned u32x2 __attribute__((ext_vector_type(2)));
typedef unsigned u32x4 __attribute__((ext_vector_type(4)));
typedef __bf16 bf16x2_t __attribute__((ext_vector_type(2)));

constexpr int NB = 2, SEQ = 8192, DM = 1024, MTOK = NB * SEQ, CTXL = 256, MCTX = NB * CTXL, FF = 4096, INW = 4096;
constexpr int NH = 8, HD = 64, NAW = 512, PW = 512, GW = 64, NROWS = SEQ / GW;
constexpr float EPS = 1e-6f;
constexpr int NPH = 8;

constexpr size_t MiB = 1u << 20;
constexpr size_t WS_CTL = 0, CTL_ZERO_BYTES = 128 * 1024;
constexpr size_t WS_SMALL = 1 * MiB;
constexpr size_t OFF_MODP = 0;
constexpr size_t OFF_MOD = 294912;
constexpr size_t OFF_TAB = OFF_MOD + 73728;
constexpr size_t OFF_BIAS2 = OFF_TAB + 16384;
constexpr size_t OFF_ROWP = OFF_BIAS2 + 32768;
static_assert(OFF_ROWP + 262144 <= MiB, "small region");
constexpr size_t WS_WTIN = 2 * MiB, WS_WTBR = 11 * MiB, WS_WTOUT = 13 * MiB, WS_WT1 = 15 * MiB, WS_WT2 = 23 * MiB;
constexpr size_t WS_KC = 31 * MiB, WS_VCT = 31 * MiB + 512 * 1024;
constexpr size_t WS_ROWP = 32 * MiB;
constexpr size_t WS_XN = 34 * MiB;
constexpr size_t WS_U = 67 * MiB, WS_QR = 83 * MiB, WS_QP = 99 * MiB, WS_KR = 115 * MiB, WS_VT = 131 * MiB, WS_SGP = 147 * MiB, WS_SGN = 179 * MiB, WS_DN = 211 * MiB;
constexpr size_t WS_ZC = 243 * MiB;
constexpr size_t WS_MG = 34 * MiB, WS_TMP = 67 * MiB, WS_XG = 67 * MiB, WS_H = 128 * MiB, WS_END = 256 * MiB;

__device__ __forceinline__ unsigned pk2(float lo, float hi) { f32x2 v = {lo, hi}; bf16x2_t b = __builtin_convertvector(v, bf16x2_t); return __builtin_bit_cast(unsigned, b); }
__device__ __forceinline__ bf16_t f2bf(float f) { return (bf16_t)(pk2(f, 0.f) & 0xffffu); }
__device__ __forceinline__ float bf2f(bf16_t h) { return __uint_as_float(((unsigned)h) << 16); }
__device__ __forceinline__ float bflo(unsigned w) { return __uint_as_float(w << 16); }
__device__ __forceinline__ float bfhi(unsigned w) { return __uint_as_float(w & 0xffff0000u); }
__device__ __forceinline__ float sigmoidf_(float x) { return __builtin_amdgcn_rcpf(1.0f + __expf(-x)); }
__device__ __forceinline__ float siluf_(float x) { return x / (1.0f + __expf(-x)); }
__device__ __forceinline__ float wave_sum(float v) {
#pragma unroll
    for (int o = 1; o < 64; o <<= 1) v += __shfl_xor(v, o);
    return v;
}
#define LDS_WAIT() asm volatile("s_waitcnt lgkmcnt(0)" ::: "memory")
#define VM_WAIT() asm volatile("s_waitcnt vmcnt(0)" ::: "memory")

__host__ __device__ __forceinline__ int inv_std(int a) { return (a & 0xE3) | ((a & 0x04) << 2) | ((a & 0x18) >> 1); }
__host__ __device__ __forceinline__ int inv_head(int a) { const int wc = a >> 6, fh = (a >> 5) & 1, bj = (a >> 4) & 1, fl = (a >> 3) & 1, n = (a >> 2) & 1, j = a & 3; return (bj << 7) | (wc << 5) | (n << 4) | (fh << 3) | (fl << 2) | j; }
__host__ __device__ __forceinline__ int fwd_std(int p) { return (p & 0xE3) | ((p & 0x0C) << 1) | ((p & 0x10) >> 2); }
__host__ __device__ __forceinline__ int wrow_std(int n) { return (n & ~255) | inv_std(n & 255); }
__host__ __device__ __forceinline__ int wrow_in(int n) { const int t = n >> 8, a = n & 255; const int p = (t >= 2 && t <= 5) ? inv_head(a) : ((t == 6 || t == 7) ? a : inv_std(a)); return (t << 8) | p; }

namespace pg8 {
constexpr int BM = 256, BK = 64, HALF = 128, HTB = HALF * BK * 2, STAGE_BYTES = 8 * HTB, NXCD = 8, WGM = 8;
__host__ __device__ __forceinline__ int lds_byte(int r, int c) { const int st = (r >> 4) * 2 + (c >> 5), rr = r & 15, cc = c & 31, ob = rr * 64 + cc * 2; return st * 1024 + (ob ^ (((ob >> 9) & 1) << 5)); }
__host__ __device__ __forceinline__ void stage_rc(int b, int& R, int& C) { const int st = b / 1024, sb = b % 1024, swz = sb ^ (((sb >> 9) & 1) << 5); R = (st >> 1) * 16 + swz / 64; C = (st & 1) * 32 + (swz % 64) / 2; }

struct Unit { int pm, pn, kind; };
struct Gemm { int ld, K; };

__device__ __forceinline__ bool static_tile(int nM, int nN, int G, int c, int i, int& pm, int& pn) {
    const int nwg = nM * nN; const long L = (long)i * G + c; if (L >= nwg) return false;
    int wgid = (int)L; { const int q = nwg / NXCD, r = nwg % NXCD, xcd = wgid % NXCD, off = wgid / NXCD; wgid = (xcd < r ? xcd * (q + 1) : r * (q + 1) + (xcd - r) * q) + off; }
    const int nig = WGM * nN, gid = wgid / nig, fm = gid * WGM, gsz = (nM - fm) < WGM ? (nM - fm) : WGM;
    pm = fm + ((wgid % nig) % gsz); pn = (wgid % nig) / gsz; return true;
}

template <class Epi, class Sched, bool ALIGN_EPI, bool SP2, bool ATILED = false>
__device__ __forceinline__ void gemm_phase(LAS unsigned char* lds, const Gemm g, const Sched& S, const Epi& E) {
    const int tid = threadIdx.x, wid = __builtin_amdgcn_readfirstlane(tid >> 6), lane = tid & 63, wr = wid >> 2, wc = wid & 3, fr = lane & 15, fq = lane >> 4;
    const int K = g.K, nt = K / BK, ld = g.ld;
    unsigned voffA[2], voffB[2];
#pragma unroll
    for (int i = 0; i < 2; ++i) { int R, C; stage_rc(tid * 16 + i * 8192, R, C); voffB[i] = (unsigned)(R * ld + C) * 2u; voffA[i] = ATILED ? (unsigned)(R * BK + C) * 2u : voffB[i]; }
    const size_t kstepB = (size_t)(BK * 2), kstepA = ATILED ? (size_t)(BM * BK * 2) : kstepB;
    const size_t hstepB = (size_t)HALF * ld * 2, hstepA = ATILED ? (size_t)(HALF * BK * 2) : hstepB;
    const unsigned ldsw = (unsigned)wid * 1024u;
    const int aoff = lds_byte(wr * 64 + fr, fq * 8), boff = lds_byte(wc * 32 + fr, fq * 8);
#define PG8_SA(b, h) (((b) * 2 + (h)) * HTB)
#define PG8_SB(b, h) ((4 + (b) * 2 + (h)) * HTB)
#define PG8_STAGEX(bufoff, gbase, vo) do { _Pragma("unroll") for (int _i = 0; _i < 2; ++_i) \
        __builtin_amdgcn_global_load_lds((const unsigned*)((const char*)(gbase) + vo[_i]), (LAS unsigned*)(lds + (bufoff) + ldsw + _i * 8192), 16, 0, 0); } while (0)
#define PG8_STAGEA(bufoff, gbase) PG8_STAGEX(bufoff, gbase, voffA)
#define PG8_STAGEB(bufoff, gbase) PG8_STAGEX(bufoff, gbase, voffB)
#define PG8_LDA(dst, b, h) do { _Pragma("unroll") for (int m = 0; m < 4; ++m) _Pragma("unroll") for (int k = 0; k < 2; ++k) dst[m][k] = *(const LAS bf16x8*)(lds + PG8_SA(b, h) + aoff + m * 2048 + k * 1024); } while (0)
#define PG8_LDB(dst, b, h) do { _Pragma("unroll") for (int n = 0; n < 2; ++n) _Pragma("unroll") for (int k = 0; k < 2; ++k) dst[n][k] = *(const LAS bf16x8*)(lds + PG8_SB(b, h) + boff + n * 2048 + k * 1024); } while (0)
#define PG8_MMA(ai, bj, At, Bt) do { __builtin_amdgcn_s_setprio(1); _Pragma("unroll") for (int m = 0; m < 4; ++m) _Pragma("unroll") for (int n = 0; n < 2; ++n) _Pragma("unroll") for (int k = 0; k < 2; ++k) \
        acc[ai][bj][m][n] = __builtin_amdgcn_mfma_f32_16x16x32_bf16(Bt[n][k], At[m][k], acc[ai][bj][m][n], 0, 0, 0); __builtin_amdgcn_s_setprio(0); } while (0)
#define PG8_WAIT_V(n) asm volatile("s_waitcnt vmcnt(" #n ")" ::: "memory")
#define PG8_WAIT_L(n) asm volatile("s_waitcnt lgkmcnt(" #n ")" ::: "memory")
#define PG8_BAR __builtin_amdgcn_s_barrier()
#define PG8_SCHED __builtin_amdgcn_sched_barrier(0)
    Unit cur, nxt; int ui = 0;
    if (!S.next(0, cur)) return;
    f32x4 acc[2][2][4][2];
#pragma unroll
    for (int a = 0; a < 2; ++a)
#pragma unroll
        for (int b = 0; b < 2; ++b)
#pragma unroll
            for (int m = 0; m < 4; ++m)
#pragma unroll
                for (int n = 0; n < 2; ++n) acc[a][b][m][n] = (f32x4){0.f, 0.f, 0.f, 0.f};
    bf16x8 At[4][2], B0[2][2], B1[2][2];
    const char* cA = S.abase(cur); const char* cB = S.bbase(cur);
    if constexpr (SP2) {
        PG8_STAGEB(PG8_SB(0, 0), cB); PG8_STAGEB(PG8_SB(0, 1), cB + hstepB); PG8_STAGEA(PG8_SA(0, 0), cA); PG8_STAGEA(PG8_SA(0, 1), cA + hstepA);
        if (wr == 1) PG8_BAR;
        PG8_WAIT_V(2); PG8_BAR;
        PG8_STAGEB(PG8_SB(1, 0), cB + kstepB); PG8_STAGEA(PG8_SA(1, 0), cA + kstepA); PG8_STAGEB(PG8_SB(1, 1), cB + hstepB + kstepB);
        PG8_WAIT_V(6); PG8_BAR;
    } else {
        PG8_STAGEB(PG8_SB(0, 0), cB); PG8_STAGEA(PG8_SA(0, 0), cA); PG8_STAGEB(PG8_SB(0, 1), cB + hstepB); PG8_STAGEA(PG8_SA(0, 1), cA + hstepA);
        if (wr == 1) PG8_BAR;
        PG8_WAIT_V(4); PG8_BAR;
        PG8_STAGEB(PG8_SB(1, 0), cB + kstepB); PG8_STAGEA(PG8_SA(1, 0), cA + kstepA); PG8_STAGEB(PG8_SB(1, 1), cB + hstepB + kstepB);
        PG8_WAIT_V(6); PG8_BAR;
    }
    for (;;) {
        const bool has_next = S.next(ui + 1, nxt);
        const char* nA = has_next ? S.abase(nxt) : cA; const char* nB = has_next ? S.bbase(nxt) : cB;
        for (int t = 0; t < nt; t += 2) {
            if constexpr (Epi::MID) { if (t == (nt >> 1)) E.mid(acc, cur, wr, wc, fr, fq); }
            const bool last = (t == nt - 2);
            const char* a1 = cA + (size_t)(t + 1) * kstepA;
            const char* a2 = last ? nA : cA + (size_t)(t + 2) * kstepA; const char* b2 = last ? nB : cB + (size_t)(t + 2) * kstepB;
            const char* a3 = a2 + kstepA; const char* b3 = b2 + kstepB;
            if constexpr (SP2) {
            PG8_LDB(B0, 0, 0); PG8_LDB(B1, 0, 1); PG8_SCHED; PG8_LDA(At, 0, 0); PG8_STAGEA(PG8_SA(1, 1), a1 + hstepA);
            PG8_WAIT_V(8); PG8_WAIT_L(0); PG8_BAR; PG8_MMA(0, 0, At, B0); PG8_MMA(0, 1, At, B1); PG8_BAR; PG8_SCHED;
            PG8_LDA(At, 0, 1); PG8_STAGEB(PG8_SB(0, 0), b2); PG8_STAGEB(PG8_SB(0, 1), b2 + hstepB); PG8_STAGEA(PG8_SA(0, 0), a2);
            PG8_WAIT_V(8); PG8_WAIT_L(0); PG8_BAR; PG8_MMA(1, 0, At, B0); PG8_MMA(1, 1, At, B1); PG8_BAR; PG8_SCHED;
            PG8_LDB(B0, 1, 0); PG8_LDB(B1, 1, 1); PG8_SCHED; PG8_LDA(At, 1, 0); PG8_STAGEA(PG8_SA(0, 1), a2 + hstepA);
            PG8_WAIT_V(8); PG8_WAIT_L(0); PG8_BAR; PG8_MMA(0, 0, At, B0); PG8_MMA(0, 1, At, B1); PG8_BAR; PG8_SCHED;
            PG8_LDA(At, 1, 1); PG8_STAGEB(PG8_SB(1, 0), b3); PG8_STAGEB(PG8_SB(1, 1), b3 + hstepB); PG8_STAGEA(PG8_SA(1, 0), a3);
            PG8_WAIT_V(8); PG8_WAIT_L(0); PG8_BAR; PG8_MMA(1, 0, At, B0); PG8_MMA(1, 1, At, B1); PG8_BAR; PG8_SCHED;
            } else {
            PG8_LDB(B0, 0, 0); PG8_SCHED; PG8_LDA(At, 0, 0); PG8_STAGEA(PG8_SA(1, 1), a1 + hstepA);
            PG8_WAIT_L(8); PG8_BAR; PG8_WAIT_L(0); PG8_MMA(0, 0, At, B0); PG8_BAR; PG8_SCHED;
            PG8_LDB(B1, 0, 1); PG8_STAGEB(PG8_SB(0, 0), b2);
            PG8_BAR; PG8_WAIT_L(0); PG8_MMA(0, 1, At, B1); PG8_BAR;
            PG8_LDA(At, 0, 1); PG8_STAGEA(PG8_SA(0, 0), a2);
            PG8_BAR; PG8_WAIT_L(0); PG8_MMA(1, 0, At, B0); PG8_BAR; PG8_SCHED;
            PG8_STAGEB(PG8_SB(0, 1), b2 + hstepB);
            PG8_WAIT_V(6); PG8_BAR; PG8_MMA(1, 1, At, B1); PG8_BAR;
            PG8_LDB(B0, 1, 0); PG8_SCHED; PG8_LDA(At, 1, 0); PG8_STAGEA(PG8_SA(0, 1), a2 + hstepA);
            PG8_WAIT_L(8); PG8_BAR; PG8_WAIT_L(0); PG8_MMA(0, 0, At, B0); PG8_BAR; PG8_SCHED;
            PG8_LDB(B1, 1, 1); PG8_STAGEB(PG8_SB(1, 0), b3);
            PG8_BAR; PG8_WAIT_L(0); PG8_MMA(0, 1, At, B1); PG8_BAR;
            PG8_LDA(At, 1, 1); PG8_STAGEA(PG8_SA(1, 0), a3);
            PG8_BAR; PG8_WAIT_L(0); PG8_MMA(1, 0, At, B0); PG8_BAR; PG8_SCHED;
            PG8_STAGEB(PG8_SB(1, 1), b3 + hstepB);
            PG8_WAIT_V(6); PG8_BAR; PG8_MMA(1, 1, At, B1); PG8_BAR;
            }
        }
        if constexpr (ALIGN_EPI) { if (wr == 0) PG8_BAR; }
        if constexpr (!Epi::AFTER_DRAIN) { E(acc, cur, wr, wc, fr, fq); }
        if (!has_next) break;
#pragma unroll
        for (int a = 0; a < 2; ++a)
#pragma unroll
            for (int b = 0; b < 2; ++b)
#pragma unroll
                for (int m = 0; m < 4; ++m)
#pragma unroll
                    for (int n = 0; n < 2; ++n) acc[a][b][m][n] = (f32x4){0.f, 0.f, 0.f, 0.f};
        cur = nxt; cA = nA; cB = nB; ++ui;
        if constexpr (ALIGN_EPI) { if (wr == 1) PG8_BAR; }
    }
    PG8_WAIT_V(0);
    if constexpr (!ALIGN_EPI) { if (wr == 0) PG8_BAR; }
    PG8_BAR;
    if constexpr (Epi::AFTER_DRAIN) { E.fused(acc, cur, wr, wc, fr, fq, lds, wid, lane); }
#undef PG8_SA
#undef PG8_SB
#undef PG8_STAGEX
#undef PG8_STAGEA
#undef PG8_STAGEB
#undef PG8_LDA
#undef PG8_LDB
#undef PG8_MMA
#undef PG8_WAIT_V
#undef PG8_WAIT_L
#undef PG8_BAR
#undef PG8_SCHED
}
}

#define XB_TMO      128
#define XB_XCNT(j)  (256  + 64 * (j))
#define XB_XSUB(j)  (1280 + 64 * (j))
#define XB_XGEN(j)  (2304 + 64 * (j))
#define XB_TOP      3328
#define XB_TOPGEN   3392
#define XCD_BAR_WORDS 3456
#define XB_SPIN_CAP (1u << 18)
__device__ __forceinline__ unsigned xb_ld(unsigned* p)              { return __hip_atomic_load(p, __ATOMIC_RELAXED, __HIP_MEMORY_SCOPE_AGENT); }
__device__ __forceinline__ unsigned xb_add(unsigned* p, unsigned v) { return __hip_atomic_fetch_add(p, v, __ATOMIC_RELAXED, __HIP_MEMORY_SCOPE_AGENT); }
__device__ __forceinline__ unsigned xb_xcc_id() { return (unsigned)__builtin_amdgcn_s_getreg((3 << 11) | 20) & 0xFu; }
#define XB_SPIN(cond, bar) do { unsigned _sp = 0; while (cond) { __builtin_amdgcn_s_sleep(1); \
    if ((++_sp & 255u) == 0u) { if (xb_ld(&(bar)[XB_TMO])) break; if (_sp > XB_SPIN_CAP) { atomicAdd(&(bar)[XB_TMO], 1u); break; } } } } while (0)
struct XcdBarrier { unsigned* bar; unsigned x; volatile LAS unsigned* st; };
__device__ __forceinline__ XcdBarrier xcd_barrier_post(unsigned* bar, volatile LAS unsigned* st) {
    XcdBarrier b; b.bar = bar; b.x = xb_xcc_id(); b.st = st;
    if (threadIdx.x == 0) (void)xb_add(&bar[XB_XCNT(b.x)], 1u);
    return b;
}
__device__ __forceinline__ void xcd_barrier_complete(unsigned* bar, unsigned x, unsigned& nloc, unsigned& nx) {
    const unsigned G = gridDim.x * gridDim.y * gridDim.z;
    unsigned sum, cnt, mine, sp = 0u;
    for (;;) {
        sum = 0u; cnt = 0u; mine = 0u;
#pragma unroll
        for (unsigned j = 0; j < 16; ++j) { const unsigned c = xb_ld(&bar[XB_XCNT(j)]); sum += c; cnt += (c > 0u) ? 1u : 0u; mine = (j == x) ? c : mine; }
        if (sum == G) break;
        __builtin_amdgcn_s_sleep(1);
        if ((++sp & 255u) == 0u) { if (xb_ld(&bar[XB_TMO])) break; if (sp > XB_SPIN_CAP) { atomicAdd(&bar[XB_TMO], 1u); break; } }
    }
    nloc = mine > 0u ? mine : 1u; nx = cnt > 0u ? cnt : 1u;
}
__device__ __forceinline__ void xcd_barrier(const XcdBarrier& b) {
    asm volatile("s_waitcnt vmcnt(0)" ::: "memory");
    __syncthreads();
    if (threadIdx.x == 0) {
        unsigned* bar = b.bar;
        __builtin_amdgcn_s_waitcnt(0);
        unsigned nloc = b.st[0], nx = b.st[1];
        if (nloc == 0u) { xcd_barrier_complete(bar, b.x, nloc, nx); b.st[0] = nloc; b.st[1] = nx; }
        const unsigned old = xb_add(&bar[XB_XSUB(b.x)], 1u);
        const unsigned gen = old / nloc;
        if (old + 1u == (gen + 1u) * nloc) {
            __builtin_amdgcn_fence(__ATOMIC_RELEASE, "agent");
            asm volatile("s_waitcnt vmcnt(0)" ::: "memory");
            const unsigned og = xb_add(&bar[XB_TOP], 1u);
            const unsigned tg = og / nx;
            if (og + 1u == (tg + 1u) * nx) xb_add(&bar[XB_TOPGEN], 1u);
            else XB_SPIN(xb_ld(&bar[XB_TOPGEN]) == tg, bar);
            __builtin_amdgcn_fence(__ATOMIC_ACQUIRE, "agent");
            xb_add(&bar[XB_XGEN(b.x)], 1u);
            asm volatile("s_waitcnt vmcnt(0)" ::: "memory");
        } else {
            XB_SPIN(xb_ld(&bar[XB_TOPGEN]) == gen, bar);
            __builtin_amdgcn_fence(__ATOMIC_ACQUIRE, "agent");
            asm volatile("s_waitcnt vmcnt(0)" ::: "memory");
        }
    }
    __syncthreads();
}

template <class Work>
__device__ __forceinline__ void xcd_barrier_shadow(const XcdBarrier& b, const Work& work) {
    asm volatile("s_waitcnt vmcnt(0)" ::: "memory");
    __syncthreads();
    if (threadIdx.x >= 64) work();
    else if (threadIdx.x == 0) {
        unsigned* bar = b.bar;
        __builtin_amdgcn_s_waitcnt(0);
        unsigned nloc = b.st[0], nx = b.st[1];
        if (nloc == 0u) { xcd_barrier_complete(bar, b.x, nloc, nx); b.st[0] = nloc; b.st[1] = nx; }
        const unsigned old = xb_add(&bar[XB_XSUB(b.x)], 1u);
        const unsigned gen = old / nloc;
        if (old + 1u == (gen + 1u) * nloc) {
            __builtin_amdgcn_fence(__ATOMIC_RELEASE, "agent");
            asm volatile("s_waitcnt vmcnt(0)" ::: "memory");
            const unsigned og = xb_add(&bar[XB_TOP], 1u);
            const unsigned tg = og / nx;
            if (og + 1u == (tg + 1u) * nx) xb_add(&bar[XB_TOPGEN], 1u);
            else XB_SPIN(xb_ld(&bar[XB_TOPGEN]) == tg, bar);
            __builtin_amdgcn_fence(__ATOMIC_ACQUIRE, "agent");
            xb_add(&bar[XB_XGEN(b.x)], 1u);
            asm volatile("s_waitcnt vmcnt(0)" ::: "memory");
        } else {
            XB_SPIN(xb_ld(&bar[XB_TOPGEN]) == gen, bar);
            __builtin_amdgcn_fence(__ATOMIC_ACQUIRE, "agent");
            asm volatile("s_waitcnt vmcnt(0)" ::: "memory");
        }
    }
    __syncthreads();
}

constexpr int NWAVES = 8;
constexpr int RING_BYTES = 131072, LDSCTL_OFF = RING_BYTES, MISC_OFF = LDSCTL_OFF + 320, LDS_BYTES = 163840;
constexpr int CW_BAR = 4096, CW_CTXROWS = 16384, CW_GEMV = 16384 + 256;

struct Ptrs {
    const float *x, *c, *ctx, *cctx, *ada_w, *ada_b, *n1g, *n2g, *w_in, *pool_w, *pool_scale, *qg, *kg, *rpb, *wbp, *wbn, *w_out, *w1, *w2;
    float* out; unsigned char* ws;
    float *modp, *mod, *bias2, *rowp; f32x2* tab;
    bf16_t *wtin, *wtbr, *wtout, *wt1, *wt2, *kc, *vct, *xn, *u, *qr, *qp, *kr, *vt, *sgp, *sgn, *dn, *mg, *xg, *xnb, *h; float *tmp, *zc;
};
struct Args { const float* in[19]; float* out; unsigned char* ws; int ph_lo, ph_hi, li, pad; };
__device__ __forceinline__ Ptrs make_ptrs(const Args& a) {
    Ptrs P;
    P.x = a.in[0]; P.c = a.in[1]; P.ctx = a.in[2]; P.cctx = a.in[3]; P.ada_w = a.in[4]; P.ada_b = a.in[5]; P.n1g = a.in[6]; P.n2g = a.in[7]; P.w_in = a.in[8]; P.pool_w = a.in[9];
    P.pool_scale = a.in[10]; P.qg = a.in[11]; P.kg = a.in[12]; P.rpb = a.in[13]; P.wbp = a.in[14]; P.wbn = a.in[15]; P.w_out = a.in[16]; P.w1 = a.in[17]; P.w2 = a.in[18];
    P.out = a.out; P.ws = a.ws; unsigned char* ws = a.ws;
    P.modp = (float*)(ws + WS_SMALL + OFF_MODP); P.mod = (float*)(ws + WS_SMALL + OFF_MOD); P.tab = (f32x2*)(ws + WS_SMALL + OFF_TAB);
    P.bias2 = (float*)(ws + WS_SMALL + OFF_BIAS2); P.rowp = (float*)(ws + WS_ROWP);
    P.wtin = (bf16_t*)(ws + WS_WTIN); P.wtbr = (bf16_t*)(ws + WS_WTBR); P.wtout = (bf16_t*)(ws + WS_WTOUT); P.wt1 = (bf16_t*)(ws + WS_WT1); P.wt2 = (bf16_t*)(ws + WS_WT2);
    P.kc = (bf16_t*)(ws + WS_KC); P.vct = (bf16_t*)(ws + WS_VCT); P.xn = (bf16_t*)(ws + WS_XN);
    P.u = (bf16_t*)(ws + WS_U); P.qr = (bf16_t*)(ws + WS_QR); P.qp = (bf16_t*)(ws + WS_QP); P.kr = (bf16_t*)(ws + WS_KR); P.vt = (bf16_t*)(ws + WS_VT);
    P.sgp = (bf16_t*)(ws + WS_SGP); P.sgn = (bf16_t*)(ws + WS_SGN); P.dn = (bf16_t*)(ws + WS_DN); P.mg = (bf16_t*)(ws + WS_MG); P.xnb = (bf16_t*)(ws + WS_XG); P.xg = (bf16_t*)a.out; P.h = (bf16_t*)(ws + WS_H);
    P.tmp = (float*)(ws + WS_TMP); P.zc = (float*)(ws + WS_ZC);
    return P;
}
struct Frame { LAS unsigned char* lds; int tid, lane, wave, vcu, G; };

template <class WMap>
__device__ __forceinline__ void wave_gemm_acc(const bf16_t* A, int lda, const bf16_t* Bt, int ldb, int K, int row0, const WMap& wmap, f32x16& d0, f32x16& d1, int lane) {
    const int r = lane & 31, hi = lane >> 5;
    const bf16_t* ap = A + (size_t)(row0 + r) * lda + 8 * hi;
    const bf16_t* bp0 = Bt + (size_t)wmap(r) * ldb + 8 * hi;
    const bf16_t* bp1 = Bt + (size_t)wmap(32 + r) * ldb + 8 * hi;
    bf16x8 a[4], b0[4], b1[4], an[4], b0n[4], b1n[4];
#define WG_LOAD(A_, B0_, B1_, k_) do { _Pragma("unroll") for (int i = 0; i < 4; ++i) { A_[i] = *(const bf16x8*)(ap + (k_) + 16 * i); B0_[i] = *(const bf16x8*)(bp0 + (k_) + 16 * i); B1_[i] = *(const bf16x8*)(bp1 + (k_) + 16 * i); } } while (0)
#define WG_MMA(A_, B0_, B1_) do { _Pragma("unroll") for (int i = 0; i < 4; ++i) { d0 = __builtin_amdgcn_mfma_f32_32x32x16_bf16(B0_[i], A_[i], d0, 0, 0, 0); d1 = __builtin_amdgcn_mfma_f32_32x32x16_bf16(B1_[i], A_[i], d1, 0, 0, 0); } } while (0)
    WG_LOAD(a, b0, b1, 0);
    for (int k = 0; k < K; k += 128) {
        WG_LOAD(an, b0n, b1n, k + 64);
        WG_MMA(a, b0, b1);
        if (k + 128 < K) WG_LOAD(a, b0, b1, k + 128);
        WG_MMA(an, b0n, b1n);
    }
#undef WG_LOAD
#undef WG_MMA
}
__device__ __forceinline__ int dcol(int blk, int reg, int hi) { return 32 * blk + (reg & 3) + 8 * (reg >> 2) + 4 * hi; }

__device__ __forceinline__ void head_norm_rope(const f32x16& d0, const f32x16& d1, const float* g, const f32x2* tab, int t, int hi, f32x16& y0, f32x16& y1, f32x16& r0, f32x16& r1) {
    float ss = 0.f;
#pragma unroll
    for (int i = 0; i < 16; ++i) ss += d0[i] * d0[i] + d1[i] * d1[i];
    ss += __shfl_xor(ss, 32);
    const float rstd = rsqrtf(ss * (1.0f / 64.0f) + EPS);
#pragma unroll
    for (int i = 0; i < 16; ++i) { y0[i] = d0[i] * rstd * g[dcol(0, i, hi)]; y1[i] = d1[i] * rstd * g[dcol(1, i, hi)]; }
    const int prow = t >> 6, pcol = t & 63;
#pragma unroll
    for (int i = 0; i < 8; ++i) {
        const int di = (i & 3) + 8 * (i >> 2) + 4 * hi;
        const f32x2 cr = tab[prow * 16 + di], cc = tab[pcol * 16 + di];
        r0[i] = y0[i] * cr.x - y0[i + 8] * cr.y; r0[i + 8] = y0[i] * cr.y + y0[i + 8] * cr.x;
        r1[i] = y1[i] * cc.x - y1[i + 8] * cc.y; r1[i + 8] = y1[i] * cc.y + y1[i + 8] * cc.x;
    }
}

template <class RM>
__device__ __forceinline__ void tr_item(const float* W, int ldw, int k0, int n0, bf16_t* Dst, int ldd, int koff, const RM& rm, LAS float* scr, int lane) {
    const int kr = lane >> 3, c4 = lane & 7;
    f32x4 v[8];
#pragma unroll
    for (int i = 0; i < 8; ++i) v[i] = __builtin_nontemporal_load((const f32x4*)(W + (size_t)(k0 + 8 * i + kr) * ldw + n0 + 4 * c4));
#pragma unroll
    for (int i = 0; i < 8; ++i) { LAS float* d = scr + (8 * i + kr) * 33 + 4 * c4; d[0] = v[i][0]; d[1] = v[i][1]; d[2] = v[i][2]; d[3] = v[i][3]; }
    LDS_WAIT(); asm volatile("" ::: "memory");
    const int c = lane & 7;
#pragma unroll
    for (int j = 0; j < 4; ++j) { const int n = (lane >> 3) + 8 * j; const LAS float* s = scr + (8 * c) * 33 + n;
        u32x4 o; o.x = pk2(s[0 * 33], s[1 * 33]); o.y = pk2(s[2 * 33], s[3 * 33]); o.z = pk2(s[4 * 33], s[5 * 33]); o.w = pk2(s[6 * 33], s[7 * 33]);
        *(u32x4*)(Dst + (size_t)rm(n0 + n) * ldd + koff + k0 + 8 * c) = o; }
    LDS_WAIT(); asm volatile("" ::: "memory");
}
struct RmIn { __device__ __forceinline__ int operator()(int n) const { return wrow_in(n); } };
struct RmStd { __device__ __forceinline__ int operator()(int n) const { return wrow_std(n); } };

__device__ __forceinline__ void late_tiles(const Frame& F, const Ptrs& P, int first, int count, int W) {
    const int w = F.wave - 1; if (w < 0 || w >= W) return;
    LAS float* scr = (LAS float*)(F.lds + w * 8704);
    for (int i = F.vcu * W + w; i < count; i += F.G * W) {
        int t = first + i; const float* src; bf16_t* dst; int ldw, ldd, nb;
        if (t < 256) { src = P.wbn; dst = P.wtbr + 512; ldw = DM; ldd = DM; nb = 32; }
        else if ((t -= 256) < 2048) { src = P.w1; dst = P.wt1; ldw = FF; ldd = DM; nb = 128; }
        else if ((t -= 2048) < 512) { src = P.w_out; dst = P.wtout; ldw = DM; ldd = DM; nb = 32; }
        else { t -= 512; src = P.w2; dst = P.wt2; ldw = DM; ldd = FF; nb = 32; }
        tr_item(src, ldw, 64 * (t / nb), 32 * (t % nb), dst, ldd, 0, RmStd(), scr, F.lane);
    }
}

__device__ __forceinline__ void phase0(const Frame& F, const Ptrs& P, int variant = 0) {
    for (int bit = F.vcu; bit < 193 && variant != 8; bit += F.G) {
      if (bit < 192) {
        const int cb = bit % 48, kq = bit / 48;
        LAS float* sl = (LAS float*)F.lds;
        for (int i = F.tid; i < 768; i += 512) { const int v = i >> 8, k = kq * 256 + (i & 255); const float cv = (v == 0) ? P.c[k] : (v == 1) ? P.c[DM + k] : P.cctx[k]; sl[i] = siluf_(cv); }
        __syncthreads();
        const int col = cb * 128 + (F.tid & 127), kg = F.tid >> 7;
        float a0 = 0.f, a1 = 0.f, a2 = 0.f;
        const float* wp = P.ada_w + (size_t)(kq * 256 + kg * 64) * 6144 + col;
        float wv[64];
#pragma unroll
        for (int k = 0; k < 64; ++k) wv[k] = __builtin_nontemporal_load(wp + (size_t)k * 6144);
#pragma unroll
        for (int k = 0; k < 64; ++k) { const float w = wv[k]; const int kk = kg * 64 + k; a0 += sl[kk] * w; a1 += sl[256 + kk] * w; a2 += sl[512 + kk] * w; }
        LAS float* pr = (LAS float*)F.lds + 1024;
        pr[(kg * 3 + 0) * 128 + (F.tid & 127)] = a0; pr[(kg * 3 + 1) * 128 + (F.tid & 127)] = a1; pr[(kg * 3 + 2) * 128 + (F.tid & 127)] = a2;
        __syncthreads();
        if (F.tid < 384) { const int v = F.tid >> 7, cl = F.tid & 127; const float s = (pr[(0 * 3 + v) * 128 + cl] + pr[(1 * 3 + v) * 128 + cl]) + (pr[(2 * 3 + v) * 128 + cl] + pr[(3 * 3 + v) * 128 + cl]);
            __hip_atomic_store(P.modp + (size_t)(kq * 3 + v) * 6144 + cb * 128 + cl, s, __ATOMIC_RELAXED, __HIP_MEMORY_SCOPE_AGENT); }
        asm volatile("s_waitcnt vmcnt(0)" ::: "memory");
        __syncthreads();
        if (F.tid == 0) __hip_atomic_fetch_add((unsigned*)(P.ws + WS_CTL) + CW_GEMV, 1u, __ATOMIC_RELAXED, __HIP_MEMORY_SCOPE_AGENT);
      } else {
        for (int i = F.tid; i < 128 * 16; i += 512) { const int pos = i >> 4, fi = i & 15; const float inv = powf(10000.0f, -(float)fi / 16.0f); const float ang = (float)pos * inv; float sn, cs; sincosf(ang, &sn, &cs); P.tab[i] = (f32x2){cs, sn}; }
      }
    }
    if (variant != 7) {
        LAS float* ts = (LAS float*)(F.lds + 16384);
        const bool full = F.G > 224;
        struct TrDesc { const float* src; bf16_t* dst; int ldw, ldd, k0, n0, isin; };
        auto item_of = [&](int rep) {
            int it;
            if (full) {
                if (F.vcu < 32) { if (rep >= 4) return 1 << 30; it = -(1 + 4 * (F.vcu >> 3) + rep); }
                else if (F.vcu < 192) { if (rep >= 1 || F.vcu >= 96) return 1 << 30; it = 128 + (F.vcu - 32); }
                else { if (rep >= 2 || F.vcu >= 256) return 1 << 30; it = (F.vcu - 192) + rep * 64; }
            } else { it = F.vcu + rep * F.G - 64; if (it < 0) it = -(1 + (it + 64)); }
            return it >= 192 ? (1 << 30) : it; };
        auto desc_of = [&](int it) { TrDesc d; int r = it;
            if (r < 0) { const int sp = -1 - r, kb = sp & 15, pnx = full ? (F.vcu & 3) : (sp >> 4); d.src = P.w_in; d.ldw = INW; d.k0 = 64 * kb; d.n0 = 256 * (4 + pnx); d.dst = P.wtin; d.ldd = DM; d.isin = 1; }
            else { const int nti = r % 12; d.src = P.w_in; d.ldw = INW; d.k0 = 64 * (r / 12); d.n0 = 256 * (nti < 4 ? nti : nti + 4); d.dst = P.wtin; d.ldd = DM; d.isin = 1; }
            return d; };
#define TRB_LOAD(v_, d_) do { _Pragma("unroll") for (int j = 0; j < 8; ++j) v_[j] = __builtin_nontemporal_load((const f32x4*)(d_.src + (size_t)(d_.k0 + F.wave + 8 * j) * d_.ldw + d_.n0 + 4 * F.lane)); } while (0)
#define TRB_FINISH(v_, d_) do { \
            _Pragma("unroll") for (int j = 0; j < 8; ++j) { LAS float* q_ = ts + (F.lane >> 3) * 2113 + (F.wave + 8 * j) * 33 + 4 * (F.lane & 7); q_[0] = v_[j][0]; q_[1] = v_[j][1]; q_[2] = v_[j][2]; q_[3] = v_[j][3]; } \
            __syncthreads(); \
            { const int c_ = F.tid & 7; \
              _Pragma("unroll") for (int j = 0; j < 4; ++j) { const int n_ = (F.tid >> 3) + 64 * j; const LAS float* q_ = ts + (n_ >> 5) * 2113 + (8 * c_) * 33 + (n_ & 31); \
                u32x4 o_; o_.x = pk2(q_[0 * 33], q_[1 * 33]); o_.y = pk2(q_[2 * 33], q_[3 * 33]); o_.z = pk2(q_[4 * 33], q_[5 * 33]); o_.w = pk2(q_[6 * 33], q_[7 * 33]); \
                const int row_ = d_.isin ? wrow_in(d_.n0 + n_) : wrow_std(d_.n0 + n_); *(u32x4*)(d_.dst + (size_t)row_ * d_.ldd + d_.k0 + 8 * c_) = o_; } } \
            __syncthreads(); } while (0)
        {
            f32x4 va[8], vb[8]; TrDesc da, db; int rep = 0;
            int ia = item_of(0);
            if (ia != (1 << 30)) { da = desc_of(ia); TRB_LOAD(va, da); }
            while (ia != (1 << 30)) {
                const int ib = item_of(rep + 1);
                if (ib != (1 << 30)) { db = desc_of(ib); TRB_LOAD(vb, db); }
                TRB_FINISH(va, da);
                if (ib == (1 << 30)) break;
                ia = item_of(rep + 2);
                if (ia != (1 << 30)) { da = desc_of(ia); TRB_LOAD(va, da); }
                TRB_FINISH(vb, db);
                rep += 2;
            }
        }
#undef TRB_LOAD
#undef TRB_FINISH
    }
}

__device__ __forceinline__ void fold_items(const Frame& F, const Ptrs& P) {
    if (F.wave < 4) return;
    LAS float* scr = (LAS float*)(F.lds + 16384 + F.wave * 12288);
    for (int r = F.vcu * 4 + F.wave - 4; r < 1024; r += F.G * 4) {
        const int n = (r & 15) * 64 + F.lane, chunk = r >> 4, g = chunk >> 4, c0 = (chunk & 15) * 8;
#pragma unroll
        for (int q = 0; q < 4; ++q) { const int idx = q * 256 + F.lane * 4; *(LAS f32x4*)(scr + idx) = *(const f32x4*)(P.pool_w + (size_t)(g * 128 + c0) * 128 + idx); }
        *(LAS f32x2*)(scr + 1024 + 2 * F.lane) = *(const f32x2*)(P.pool_scale + g * 128 + 2 * F.lane);
        LDS_WAIT(); asm volatile("" ::: "memory");
        float acc[8];
#pragma unroll
        for (int i = 0; i < 8; ++i) acc[i] = 0.f;
        const float* wp = P.wbp + (size_t)(g * 128) * DM + n;
        for (int e0 = 0; e0 < 128; e0 += 64) {
            float wv[64];
#pragma unroll
            for (int e = 0; e < 64; ++e) wv[e] = __builtin_nontemporal_load(wp + (size_t)(e0 + e) * DM);
#pragma unroll
            for (int e = 0; e < 64; ++e) { const float w = wv[e] * scr[1024 + e0 + e];
#pragma unroll
                for (int i = 0; i < 8; ++i) acc[i] += scr[i * 128 + e0 + e] * w; }
        }
        u32x4 o; o.x = pk2(acc[0], acc[1]); o.y = pk2(acc[2], acc[3]); o.z = pk2(acc[4], acc[5]); o.w = pk2(acc[6], acc[7]);
        *(u32x4*)(P.wtbr + (size_t)wrow_std(n) * DM + g * 128 + c0) = o;
        LDS_WAIT(); asm volatile("" ::: "memory");
    }
}

__device__ __forceinline__ float modsum(const float* modp, int v, int col) { return (modp[(size_t)(0 * 3 + v) * 6144 + col] + modp[(size_t)(1 * 3 + v) * 6144 + col]) + (modp[(size_t)(2 * 3 + v) * 6144 + col] + modp[(size_t)(3 * 3 + v) * 6144 + col]); }
__device__ __forceinline__ void phase1(const Frame& F, const Ptrs& P) {
    const bool ctxwg = (F.G > 32) && (F.vcu < 32);
    const int gwl = (F.G > 32 ? F.vcu - 32 : F.vcu) * NWAVES + F.wave, NGWL = ((F.G > 32) ? F.G - 32 : F.G) * NWAVES;
    const int nitv = (SEQ + 5 * NGWL - 1) / (5 * NGWL), NIT = 2 * nitv;
    LAS float* tb = (LAS float*)F.lds;
#define ROWS_LOAD(xv_, it_) do { const int v_ = (it_) / nitv, m0_ = gwl + ((it_) % nitv) * 5 * NGWL; \
        _Pragma("unroll") for (int q = 0; q < 5; ++q) { const int m = min(m0_ + q * NGWL, SEQ - 1); const float* xrow = P.x + ((size_t)v_ * SEQ + m) * DM; \
            _Pragma("unroll") for (int j = 0; j < 4; ++j) xv_[q][j] = __builtin_nontemporal_load((const f32x4*)(xrow + 256 * j + 4 * F.lane)); } } while (0)
#define ROWS_FINISH(xv_, it_) do { const int v_ = (it_) / nitv, m0_ = gwl + ((it_) % nitv) * 5 * NGWL; f32x4 sc[4], sh[4]; \
        _Pragma("unroll") for (int j = 0; j < 4; ++j) { sc[j] = *(const LAS f32x4*)(tb + (v_ * 2 + 0) * 1024 + 256 * j + 4 * F.lane); sh[j] = *(const LAS f32x4*)(tb + (v_ * 2 + 1) * 1024 + 256 * j + 4 * F.lane); } \
        _Pragma("unroll") for (int q = 0; q < 5; ++q) { const int m = m0_ + q * NGWL; if (m < SEQ) { \
            bf16_t* orow = P.xn + ((size_t)v_ * SEQ + m) * DM; float sq = 0.f; \
            _Pragma("unroll") for (int j = 0; j < 4; ++j) sq += (xv_[q][j].x * xv_[q][j].x + xv_[q][j].y * xv_[q][j].y) + (xv_[q][j].z * xv_[q][j].z + xv_[q][j].w * xv_[q][j].w); \
            const float rstd = rsqrtf(wave_sum(sq) * (1.0f / DM) + EPS); \
            _Pragma("unroll") for (int j = 0; j < 4; ++j) { const f32x4 o = xv_[q][j] * rstd * sc[j] + sh[j]; u32x2 w; w.x = pk2(o.x, o.y); w.y = pk2(o.z, o.w); *(u32x2*)(orow + 256 * j + 4 * F.lane) = w; } } } } while (0)
    f32x4 xa[5][4], xb[5][4], xc[4];
    if (!ctxwg) ROWS_LOAD(xa, 0);
    const int mc = F.vcu + F.G * F.wave;
    if (mc < MCTX) {
#pragma unroll
        for (int j = 0; j < 4; ++j) xc[j] = __builtin_nontemporal_load((const f32x4*)(P.ctx + (size_t)mc * DM + 256 * j + 4 * F.lane)); }
    if (F.tid == 0) { unsigned* c = (unsigned*)(P.ws + WS_CTL) + CW_GEMV; unsigned sp = 0;
        while (__hip_atomic_load(c, __ATOMIC_RELAXED, __HIP_MEMORY_SCOPE_AGENT) < 192u) { __builtin_amdgcn_s_sleep(2); if (++sp > (1u << 20)) break; }
        __builtin_amdgcn_fence(__ATOMIC_ACQUIRE, "agent"); asm volatile("s_waitcnt vmcnt(0)" ::: "memory"); }
    __syncthreads();
    for (int i = F.vcu * 512 + F.tid; i < 3 * 6144; i += F.G * 512) { const int v = i / 6144, col = i % 6144; P.mod[i] = modsum(P.modp, v, col) + P.ada_b[col]; }
#pragma unroll
    for (int i0 = 0; i0 < 3 * 1024; i0 += 512) { const int i = i0 + F.tid, v = i >> 10, col = i & 1023;
        tb[(v * 2 + 0) * 1024 + col] = P.n1g[col] * (1.0f + modsum(P.modp, v, 1024 + col) + P.ada_b[1024 + col]); tb[(v * 2 + 1) * 1024 + col] = modsum(P.modp, v, col) + P.ada_b[col]; }
    __syncthreads();
    unsigned* cnt = (unsigned*)(P.ws + WS_CTL) + CW_CTXROWS;
    {
        f32x4 sc[4], sh[4];
#pragma unroll
        for (int j = 0; j < 4; ++j) { sc[j] = *(const LAS f32x4*)(tb + 4 * 1024 + 256 * j + 4 * F.lane); sh[j] = *(const LAS f32x4*)(tb + 5 * 1024 + 256 * j + 4 * F.lane); }
        for (int m = mc; m < MCTX; m += F.G * NWAVES) {
            bf16_t* orow = P.xn + ((size_t)MTOK + m) * DM;
            if (m != mc) {
#pragma unroll
                for (int j = 0; j < 4; ++j) xc[j] = __builtin_nontemporal_load((const f32x4*)(P.ctx + (size_t)m * DM + 256 * j + 4 * F.lane)); }
            float sq = 0.f;
#pragma unroll
            for (int j = 0; j < 4; ++j) sq += (xc[j].x * xc[j].x + xc[j].y * xc[j].y) + (xc[j].z * xc[j].z + xc[j].w * xc[j].w);
            const float rstd = rsqrtf(wave_sum(sq) * (1.0f / DM) + EPS);
#pragma unroll
            for (int j = 0; j < 4; ++j) { const f32x4 o = xc[j] * rstd * sc[j] + sh[j];
                __hip_atomic_store((unsigned long long*)(orow + 256 * j + 4 * F.lane), (unsigned long long)pk2(o.x, o.y) | ((unsigned long long)pk2(o.z, o.w) << 32), __ATOMIC_RELAXED, __HIP_MEMORY_SCOPE_AGENT); }
            asm volatile("s_waitcnt vmcnt(0)" ::: "memory");
            if (F.lane == 0) __hip_atomic_fetch_add(cnt + 64 * (m >> 8), 1u, __ATOMIC_RELAXED, __HIP_MEMORY_SCOPE_AGENT);
        }
    }
    if (!ctxwg) {
        for (int it = 0;;) {
            if (it + 1 < NIT) ROWS_LOAD(xb, it + 1);
            ROWS_FINISH(xa, it);
            if (it + 1 >= NIT) break;
            if (it + 2 < NIT) ROWS_LOAD(xa, it + 2);
            ROWS_FINISH(xb, it + 1);
            it += 2; if (it >= NIT) break;
        }
    }
#undef ROWS_LOAD
#undef ROWS_FINISH
    if (ctxwg) {
        if (F.tid == 0) { unsigned* c = cnt + 64 * ((F.vcu >> 2) & 1); unsigned sp = 0;
            while (__hip_atomic_load(c, __ATOMIC_RELAXED, __HIP_MEMORY_SCOPE_AGENT) < 256u) { __builtin_amdgcn_s_sleep(2); if (++sp > (1u << 20)) break; }
            __builtin_amdgcn_fence(__ATOMIC_ACQUIRE, "agent"); asm volatile("s_waitcnt vmcnt(0)" ::: "memory"); }
    }
    VM_WAIT();
    __syncthreads();
}
__device__ __forceinline__ void bias2_items(const Frame& F, const Ptrs& P, int gw, int NGW) {
    float h0[16], h1[16];
#pragma unroll
    for (int q = 0; q < 4; ++q) { const f32x4 a = *(const f32x4*)(P.mod + 3072 + 16 * F.lane + 4 * q), b = *(const f32x4*)(P.mod + 6144 + 3072 + 16 * F.lane + 4 * q);
#pragma unroll
        for (int e = 0; e < 4; ++e) { h0[4 * q + e] = a[e]; h1[4 * q + e] = b[e]; } }
    for (int p = gw; p < FF; p += NGW) {
        const bf16_t* wr = P.wt1 + (size_t)p * DM + 16 * F.lane;
        const u32x4 w0 = *(const u32x4*)wr, w1 = *(const u32x4*)(wr + 8);
        float wf[16]; wf[0] = bflo(w0.x); wf[1] = bfhi(w0.x); wf[2] = bflo(w0.y); wf[3] = bfhi(w0.y); wf[4] = bflo(w0.z); wf[5] = bfhi(w0.z); wf[6] = bflo(w0.w); wf[7] = bfhi(w0.w);
        wf[8] = bflo(w1.x); wf[9] = bfhi(w1.x); wf[10] = bflo(w1.y); wf[11] = bfhi(w1.y); wf[12] = bflo(w1.z); wf[13] = bfhi(w1.z); wf[14] = bflo(w1.w); wf[15] = bfhi(w1.w);
        float s0 = 0.f, s1 = 0.f;
#pragma unroll
        for (int e = 0; e < 16; ++e) { s0 += h0[e] * wf[e]; s1 += h1[e] * wf[e]; }
        s0 = wave_sum(s0); s1 = wave_sum(s1);
        if (F.lane == 0) { const int col = (p & ~255) | fwd_std(p & 255); P.bias2[col] = s0; P.bias2[FF + col] = s1; }
    }
}

__host__ __device__ __forceinline__ size_t kr_index(int b, int t, int h, int d) { const int r = t >> 6, col = t & 63, quad = col >> 2, eq = quad >> 1, par = quad & 1;
    return (size_t)((b * NROWS + r) * NH + h) * 4096 + ((((d >> 5) * 4 + ((d >> 3) & 3)) * 2 + par) * 2 + (eq >> 2)) * 128 + ((col & 3) * 4 + (eq & 3)) * 8 + (d & 7); }
__host__ __device__ __forceinline__ size_t vt_index(int b, int h, int d, int t) { const int r = t >> 6, col = t & 63;
    return (((size_t)((b * NROWS + r) * NH + h) * 8 + (col >> 3)) * 64 + d) * 8 + (col & 7); }

__host__ __device__ __forceinline__ size_t kc_index(int b, int n, int h, int d) { const int g = n >> 5, nn = n & 31, hb = (nn >> 2) & 1, m = 4 * (nn >> 3) + (nn & 3), s = d >> 5, fq = (d >> 3) & 3, j = d & 7;
    return (size_t)((((b * NH + h) * 8 + g) * 2 + hb) * 2 + s) * 512 + (m + 16 * fq) * 8 + j; }
__host__ __device__ __forceinline__ size_t vct_index(int b, int h, int d, int n) { const int g = n >> 5, fq = (n >> 3) & 3, j = n & 7, db = d >> 4, qi = d & 15;
    return (size_t)(((b * NH + h) * 8 + g) * 4 + db) * 512 + (qi + 16 * fq) * 8 + j; }

struct WmIn { int c0; __device__ __forceinline__ int operator()(int i) const { return wrow_in(c0 + i); } };
__device__ __forceinline__ void ctx_kv(const Frame& F, const Ptrs& P) {
    const int gw = F.vcu * NWAVES + F.wave, NGW = F.G * NWAVES;
    for (int it = gw; it < 256; it += NGW) {
        const int rt = it & 15, ht = it >> 4, row0 = rt * 32, hi = F.lane >> 5, r = F.lane & 31;
        f32x16 d0 = {}, d1 = {};
        WmIn wm{1024 + 64 * ht};
        wave_gemm_acc(P.xn + (size_t)MTOK * DM, DM, P.wtin, DM, DM, row0, wm, d0, d1, F.lane);
        const int crow = row0 + r;
        if (ht < 8) {
            float ss = 0.f;
#pragma unroll
            for (int i = 0; i < 16; ++i) ss += d0[i] * d0[i] + d1[i] * d1[i];
            ss += __shfl_xor(ss, 32);
            const float rstd = rsqrtf(ss * (1.0f / 64.0f) + EPS);
#pragma unroll
            for (int i = 0; i < 16; ++i) { const int c0 = dcol(0, i, hi), c1 = dcol(1, i, hi); P.kc[kc_index(crow >> 8, crow & 255, ht, c0)] = f2bf(d0[i] * rstd * P.kg[c0]); P.kc[kc_index(crow >> 8, crow & 255, ht, c1)] = f2bf(d1[i] * rstd * P.kg[c1]); }
        } else {
            const int h = ht - 8, b = crow >> 8, n = crow & 255;
#pragma unroll
            for (int i = 0; i < 16; ++i) { const int c0 = dcol(0, i, hi), c1 = dcol(1, i, hi); P.vct[vct_index(b, h, c0, n)] = f2bf(d0[i]); P.vct[vct_index(b, h, c1, n)] = f2bf(d1[i]); }
        }
    }
}

__device__ __forceinline__ void pool_item(const Ptrs& P, int row, int chunk) {
    const int b = row >> 13, t = row & (SEQ - 1), w = 2 << (chunk >> 4);
    const int lo = max(t - (w >> 1), 0), hi = min(t + (w >> 1), SEQ);
    float s[8];
#pragma unroll
    for (int i = 0; i < 8; ++i) s[i] = 0.f;
    for (int tt = lo; tt < hi; ++tt) { const u32x4 v = *(const u32x4*)(P.u + ((size_t)b * SEQ + tt) * PW + chunk * 8);
        s[0] += bflo(v.x); s[1] += bfhi(v.x); s[2] += bflo(v.y); s[3] += bfhi(v.y); s[4] += bflo(v.z); s[5] += bfhi(v.z); s[6] += bflo(v.w); s[7] += bfhi(v.w); }
    const u32x4 c = *(const u32x4*)(P.u + (size_t)row * PW + chunk * 8);
    const float inv = 1.0f / (float)(hi - lo);
    u32x4 o; o.x = pk2(s[0] * inv - bflo(c.x), s[1] * inv - bfhi(c.x)); o.y = pk2(s[2] * inv - bflo(c.y), s[3] * inv - bfhi(c.y));
    o.z = pk2(s[4] * inv - bflo(c.z), s[5] * inv - bfhi(c.z)); o.w = pk2(s[6] * inv - bflo(c.w), s[7] * inv - bfhi(c.w));
    *(u32x4*)(P.dn + (size_t)row * DM + chunk * 8) = o;
}
template <int W> __device__ __forceinline__ void pool_item_w(const Ptrs& P, int row, int chunk) {
    const int b = row >> 13, t = row & (SEQ - 1);
    const int lo = max(t - W / 2, 0), hi = min(t + W / 2, SEQ);
    u32x4 v[W];
#pragma unroll
    for (int i = 0; i < W; ++i) { const int tt = min(max(t - W / 2 + i, 0), SEQ - 1); v[i] = *(const u32x4*)(P.u + ((size_t)b * SEQ + tt) * PW + chunk * 8); }
    float s[8];
#pragma unroll
    for (int i = 0; i < 8; ++i) s[i] = 0.f;
#pragma unroll
    for (int i = 0; i < W; ++i) { const int tt = t - W / 2 + i; const float m = (tt >= 0 && tt < SEQ) ? 1.0f : 0.0f;
        s[0] += m * bflo(v[i].x); s[1] += m * bfhi(v[i].x); s[2] += m * bflo(v[i].y); s[3] += m * bfhi(v[i].y); s[4] += m * bflo(v[i].z); s[5] += m * bfhi(v[i].z); s[6] += m * bflo(v[i].w); s[7] += m * bfhi(v[i].w); }
    const u32x4 c = v[W / 2];
    const float inv = 1.0f / (float)(hi - lo);
    u32x4 o; o.x = pk2(s[0] * inv - bflo(c.x), s[1] * inv - bfhi(c.x)); o.y = pk2(s[2] * inv - bflo(c.y), s[3] * inv - bfhi(c.y));
    o.z = pk2(s[4] * inv - bflo(c.z), s[5] * inv - bfhi(c.z)); o.w = pk2(s[6] * inv - bflo(c.w), s[7] * inv - bfhi(c.w));
    *(u32x4*)(P.dn + (size_t)row * DM + chunk * 8) = o;
}

template <int W> __device__ __forceinline__ void pool_seg8(const Ptrs& P, int b, int t0, int chunk) {
    const bf16_t* ub = P.u + (size_t)b * SEQ * PW + chunk * 8;
    auto ld = [&](int t) { return *(const u32x4*)(ub + (size_t)min(max(t, 0), SEQ - 1) * PW); };
    auto acc = [&](float (&s)[8], const u32x4& v, float m) { s[0] += m * bflo(v.x); s[1] += m * bfhi(v.x); s[2] += m * bflo(v.y); s[3] += m * bfhi(v.y); s[4] += m * bflo(v.z); s[5] += m * bfhi(v.z); s[6] += m * bflo(v.w); s[7] += m * bfhi(v.w); };
    u32x4 w[W];
#pragma unroll
    for (int i = 0; i < W; ++i) w[i] = ld(t0 - W / 2 + i);
    u32x4 vin[7], vout[7], cen[8];
#pragma unroll
    for (int i = 0; i < 7; ++i) { vin[i] = ld(t0 + i + W / 2); vout[i] = ld(t0 + i - W / 2); }
#pragma unroll
    for (int i = 0; i < 8; ++i) cen[i] = (i < W / 2) ? w[W / 2 + i] : vin[i - W / 2];
    float s[8];
#pragma unroll
    for (int e = 0; e < 8; ++e) s[e] = 0.f;
#pragma unroll
    for (int i = 0; i < W; ++i) { const int t = t0 - W / 2 + i; acc(s, w[i], (t >= 0 && t < SEQ) ? 1.0f : 0.0f); }
#pragma unroll
    for (int i = 0; i < 8; ++i) {
        const int t = t0 + i, lo = max(t - W / 2, 0), hi = min(t + W / 2, SEQ);
        const float inv = 1.0f / (float)(hi - lo); const u32x4 c = cen[i];
        u32x4 o; o.x = pk2(s[0] * inv - bflo(c.x), s[1] * inv - bfhi(c.x)); o.y = pk2(s[2] * inv - bflo(c.y), s[3] * inv - bfhi(c.y));
        o.z = pk2(s[4] * inv - bflo(c.z), s[5] * inv - bfhi(c.z)); o.w = pk2(s[6] * inv - bflo(c.w), s[7] * inv - bfhi(c.w));
        *(u32x4*)(P.dn + ((size_t)b * SEQ + t) * DM + chunk * 8) = o;
        if (i < 7) { acc(s, vin[i], (t + W / 2 < SEQ) ? 1.0f : 0.0f); acc(s, vout[i], (t - W / 2 >= 0) ? -1.0f : 0.0f); }
    }
}

struct WmStd { int c0; __device__ __forceinline__ int operator()(int i) const { return wrow_std(c0 + i); } };
__global__ void __launch_bounds__(512) naive_g1(Args a) {
    const Ptrs P = make_ptrs(a); Frame F; F.tid = threadIdx.x; F.lane = F.tid & 63; F.wave = F.tid >> 6; F.vcu = blockIdx.x; F.G = gridDim.x; F.lds = nullptr;
    ctx_kv(F, P);
    const int gw = blockIdx.x * 8 + F.wave, NGW = gridDim.x * 8, lane = F.lane, hi = lane >> 5, r = lane & 31;
    for (int it = gw; it < (MTOK / 32) * (INW / 64); it += NGW) {
        const int ct = it % (INW / 64), rt = it / (INW / 64), row0 = rt * 32, col0 = ct * 64, row = row0 + r;
        f32x16 d0 = {}, d1 = {};
        WmIn wm{col0};
        wave_gemm_acc(P.xn, DM, P.wtin, DM, DM, row0, wm, d0, d1, lane);
        if (col0 < 512) {
#pragma unroll
            for (int i = 0; i < 16; ++i) { P.u[(size_t)row * PW + col0 + dcol(0, i, hi)] = f2bf(d0[i]); P.u[(size_t)row * PW + col0 + dcol(1, i, hi)] = f2bf(d1[i]); }
        } else if (col0 < 1536) {
            const bool isq = col0 < 1024; const int h = ((col0 - 512) & 511) >> 6;
            f32x16 y0, y1, r0, r1;
            head_norm_rope(d0, d1, isq ? P.qg : P.kg, P.tab, row & (SEQ - 1), hi, y0, y1, r0, r1);
#pragma unroll
            for (int i = 0; i < 16; ++i) { const size_t o0 = (size_t)row * NAW + h * 64 + dcol(0, i, hi), o1 = (size_t)row * NAW + h * 64 + dcol(1, i, hi);
                if (isq) { P.qp[o0] = f2bf(0.125f * y0[i]); P.qp[o1] = f2bf(0.125f * y1[i]); P.qr[o0] = f2bf(0.125f * r0[i]); P.qr[o1] = f2bf(0.125f * r1[i]); }
                else { P.kr[kr_index(row >> 13, row & (SEQ - 1), h, dcol(0, i, hi))] = f2bf(r0[i]); P.kr[kr_index(row >> 13, row & (SEQ - 1), h, dcol(1, i, hi))] = f2bf(r1[i]); } }
        } else if (col0 < 2048) {
            const int h = (col0 - 1536) >> 6, b = row >> 13, t = row & (SEQ - 1);
#pragma unroll
            for (int i = 0; i < 16; ++i) { P.vt[vt_index(b, h, dcol(0, i, hi), t)] = f2bf(d0[i]); P.vt[vt_index(b, h, dcol(1, i, hi), t)] = f2bf(d1[i]); }
        } else {
            bf16_t* dst = (col0 < 3072) ? P.sgp : P.sgn; const int cb = (col0 < 3072) ? col0 - 2048 : col0 - 3072;
#pragma unroll
            for (int i = 0; i < 16; ++i) { dst[(size_t)row * DM + cb + dcol(0, i, hi)] = f2bf(sigmoidf_(d0[i])); dst[(size_t)row * DM + cb + dcol(1, i, hi)] = f2bf(sigmoidf_(d1[i])); }
        }
    }
}
__global__ void __launch_bounds__(256) naive_attn(Args a) {
    const Ptrs P = make_ptrs(a);
    for (int i = blockIdx.x * 256 + threadIdx.x; i < MTOK * 64; i += gridDim.x * 256) pool_item(P, i >> 6, i & 63);
    for (int i = blockIdx.x * 256 + threadIdx.x; i < MTOK * NH; i += gridDim.x * 256) {
        const int h = i & 7, row = i >> 3, b = row >> 13, t = row & (SEQ - 1), r = t >> 6, c = t & 63;
        const int r0 = min(max(r - 4, 0), NROWS - 8), c0 = min(max(c - 8, 0), GW - 16);
        float q[64], qp[64], o[64];
#pragma unroll
        for (int d = 0; d < 64; ++d) { q[d] = bf2f(P.qr[(size_t)row * NAW + h * 64 + d]); qp[d] = bf2f(P.qp[(size_t)row * NAW + h * 64 + d]); o[d] = 0.f; }
        float mx = -1e30f, l = 0.f;
        for (int kk = 0; kk < 128 + CTXL; ++kk) {
            float s = 0.f;
            if (kk < 128) { const int kr = r0 + (kk >> 4), kcn = c0 + (kk & 15);
#pragma unroll
                for (int d = 0; d < 64; ++d) s += q[d] * bf2f(P.kr[kr_index(b, kr * 64 + kcn, h, d)]);
                s += P.rpb[(h * 15 + (kr - r + 7)) * 31 + (kcn - c + 15)];
            } else { const int n = kk - 128;
#pragma unroll
                for (int d = 0; d < 64; ++d) s += qp[d] * bf2f(P.kc[kc_index(b, n, h, d)]); }
            const float mn = fmaxf(mx, s), f = __expf(mx - mn), p = __expf(s - mn);
            l = l * f + p;
#pragma unroll
            for (int d = 0; d < 64; ++d) o[d] = o[d] * f + p * bf2f(kk < 128 ? P.vt[vt_index(b, h, d, (r0 + (kk >> 4)) * 64 + c0 + (kk & 15))] : P.vct[vct_index(b, h, d, kk - 128)]);
            mx = mn;
        }
        const float il = 1.0f / l;
#pragma unroll
        for (int d = 0; d < 64; ++d) P.dn[(size_t)row * DM + 512 + h * 64 + d] = f2bf(o[d] * il);
    }
}
__global__ void __launch_bounds__(512) naive_g2(Args a) {
    const Ptrs P = make_ptrs(a); const int lane = threadIdx.x & 63, hi = lane >> 5, r = lane & 31;
    const int gw = blockIdx.x * 8 + (threadIdx.x >> 6), NGW = gridDim.x * 8;
    for (int it = gw; it < (MTOK / 32) * (DM / 64); it += NGW) {
        const int ct = it % (DM / 64), rt = it / (DM / 64), row0 = rt * 32, col0 = ct * 64, row = row0 + r;
        f32x16 d0 = {}, d1 = {}, e0 = {}, e1 = {};
        WmStd wm{col0};
        wave_gemm_acc(P.dn, DM, P.wtbr, DM, 512, row0, wm, d0, d1, lane);
        wave_gemm_acc(P.dn + 512, DM, P.wtbr + 512, DM, 512, row0, wm, e0, e1, lane);
#pragma unroll
        for (int i = 0; i < 16; ++i) { const size_t o0 = (size_t)row * DM + col0 + dcol(0, i, hi), o1 = (size_t)row * DM + col0 + dcol(1, i, hi);
            P.mg[o0] = f2bf(bf2f(P.sgp[o0]) * d0[i] + bf2f(P.sgn[o0]) * e0[i]); P.mg[o1] = f2bf(bf2f(P.sgp[o1]) * d1[i] + bf2f(P.sgn[o1]) * e1[i]); }
    }
}
__global__ void __launch_bounds__(512) naive_g3(Args a) {
    const Ptrs P = make_ptrs(a); const int lane = threadIdx.x & 63, hi = lane >> 5, r = lane & 31;
    const int gw = blockIdx.x * 8 + (threadIdx.x >> 6), NGW = gridDim.x * 8;
    for (int it = gw; it < (MTOK / 32) * 4; it += NGW) {
        const int pn = it & 3, rt = it >> 2, row0 = rt * 32, row = row0 + r, b = row >> 13;
        for (int q = 0; q < 4; ++q) {
            float ss = 0.f;
            const int col0 = pn * 256 + q * 64;
            f32x16 d0 = {}, d1 = {};
            WmStd wm{col0};
            wave_gemm_acc(P.mg, DM, P.wtout, DM, DM, row0, wm, d0, d1, lane);
#pragma unroll
            for (int i = 0; i < 16; ++i)
#pragma unroll
                for (int blk = 0; blk < 2; ++blk) { const int col = col0 + dcol(blk, i, hi); const size_t o = (size_t)row * DM + col;
                    const float xn = P.x[o] + P.mod[b * 6144 + 2048 + col] * (blk ? d1[i] : d0[i]);
                    P.xnb[o] = f2bf(xn); P.xg[o] = f2bf(xn * P.n2g[col] * (1.0f + P.mod[b * 6144 + 4096 + col])); ss += xn * xn; }
            ss += __shfl_xor(ss, 32);
            if (hi == 0) P.rowp[(size_t)row * 16 + pn * 4 + q] = ss;
        }
    }
}
__global__ void __launch_bounds__(512) naive_g4(Args a) {
    const Ptrs P = make_ptrs(a); const int lane = threadIdx.x & 63, hi = lane >> 5, r = lane & 31;
    const int gw = blockIdx.x * 8 + (threadIdx.x >> 6), NGW = gridDim.x * 8;
    for (int it = gw; it < (MTOK / 32) * (FF / 64); it += NGW) {
        const int ct = it % (FF / 64), rt = it / (FF / 64), row0 = rt * 32, col0 = ct * 64, row = row0 + r, b = row >> 13;
        f32x16 d0 = {}, d1 = {};
        WmStd wm{col0};
        wave_gemm_acc(P.xg, DM, P.wt1, DM, DM, row0, wm, d0, d1, lane);
        float sq = 0.f;
#pragma unroll
        for (int q = 0; q < 4; ++q) { const f32x4 rp = *(const f32x4*)(P.rowp + (size_t)row * 16 + 4 * q); sq += (rp.x + rp.y) + (rp.z + rp.w); }
        const float rstd = rsqrtf(sq * (1.0f / DM) + EPS);
#pragma unroll
        for (int i = 0; i < 16; ++i)
#pragma unroll
            for (int blk = 0; blk < 2; ++blk) { const int col = col0 + dcol(blk, i, hi); const float v = fmaxf(rstd * (blk ? d1[i] : d0[i]) + P.bias2[b * FF + col], 0.f); P.h[(size_t)row * FF + col] = f2bf(v * v); }
    }
}
__global__ void __launch_bounds__(512) naive_g5(Args a) {
    const Ptrs P = make_ptrs(a); const int lane = threadIdx.x & 63, hi = lane >> 5, r = lane & 31;
    const int gw = blockIdx.x * 8 + (threadIdx.x >> 6), NGW = gridDim.x * 8;
    for (int it = gw; it < (MTOK / 32) * (DM / 64); it += NGW) {
        const int ct = it % (DM / 64), rt = it / (DM / 64), row0 = rt * 32, col0 = ct * 64, row = row0 + r, b = row >> 13;
        f32x16 d0 = {}, d1 = {};
        WmStd wm{col0};
        wave_gemm_acc(P.h, FF, P.wt2, FF, FF, row0, wm, d0, d1, lane);
#pragma unroll
        for (int i = 0; i < 16; ++i)
#pragma unroll
            for (int blk = 0; blk < 2; ++blk) { const int col = col0 + dcol(blk, i, hi); const size_t o = (size_t)row * DM + col; P.out[o] = bf2f(P.xnb[o]) + P.mod[b * 6144 + 5120 + col] * (blk ? d1[i] : d0[i]); }
    }
}


constexpr size_t TILEB = 256 * 2;
struct SchedG1 {
    const char *xn, *wt; int G, c;
    __device__ __forceinline__ bool next(int i, pg8::Unit& u) const { if (!pg8::static_tile(MTOK / 256, INW / 256, G, c, i, u.pm, u.pn)) return false; u.kind = (u.pn == 6 || u.pn == 7) ? 1 : 0; return true; }
    __device__ __forceinline__ const char* abase(const pg8::Unit& u) const { return u.kind ? wt + (size_t)(256 * u.pn) * (DM * 2) : xn + (size_t)(256 * u.pm) * (DM * 2); }
    __device__ __forceinline__ const char* bbase(const pg8::Unit& u) const { return u.kind ? xn + (size_t)(256 * u.pm) * (DM * 2) : wt + (size_t)(256 * u.pn) * (DM * 2); }
};
struct SchedG2 {
    const char *dn, *wt; int G, c;
    __device__ __forceinline__ bool next(int i, pg8::Unit& u) const { if (!pg8::static_tile(MTOK / 256, DM / 256, G, c, i >> 1, u.pm, u.pn)) return false; u.kind = i & 1; return true; }
    __device__ __forceinline__ const char* abase(const pg8::Unit& u) const { return dn + (size_t)(256 * u.pm) * (DM * 2) + u.kind * 1024; }
    __device__ __forceinline__ const char* bbase(const pg8::Unit& u) const { return wt + (size_t)(256 * u.pn) * (DM * 2) + u.kind * 1024; }
};
struct SchedStd {
    const char *a, *b; int nM, nN, ldb2, G, c;
    __device__ __forceinline__ bool next(int i, pg8::Unit& u) const { if (!pg8::static_tile(nM, nN, G, c, i, u.pm, u.pn)) return false; u.kind = i; return true; }
    __device__ __forceinline__ const char* abase(const pg8::Unit& u) const { return a + (size_t)(256 * u.pm) * ldb2; }
    __device__ __forceinline__ const char* bbase(const pg8::Unit& u) const { return b + (size_t)(256 * u.pn) * ldb2; }
};
typedef f32x4 acc_t[2][2][4][2];
__host__ __device__ __forceinline__ size_t t1k_index(int row, int col) { return ((size_t)((row >> 8) * (DM / 64) + (col >> 6)) * 256 + (row & 255)) * 64 + (col & 63); }
__host__ __device__ __forceinline__ size_t h_index(int row, int col) { return ((size_t)((row >> 8) * (FF / 64) + (col >> 6)) * 256 + (row & 255)) * 64 + (col & 63); }

struct EpiG1 {
    static constexpr bool AFTER_DRAIN = false, MID = false;
    bf16_t *u, *qr, *qp, *kr, *vt, *sgp, *sgn; const float *qg, *kg; const f32x2* tab; int skip;
    __device__ __forceinline__ void operator()(const acc_t& acc, const pg8::Unit& un, int wr, int wc, int fr, int fq) const {
        const int pn = un.pn;
        if (skip == 5) return;
        if (un.kind == 1) {
            const int b = un.pm >> 5, t0 = (un.pm & 31) * 256 + 32 * wc + 4 * fq;
#pragma unroll
            for (int ai = 0; ai < 2; ++ai)
#pragma unroll
                for (int m = 0; m < 4; ++m) { const int ch = 256 * (pn - 6) + 128 * ai + 64 * wr + 16 * m + fr;
#pragma unroll
                    for (int bj = 0; bj < 2; ++bj)
#pragma unroll
                        for (int n = 0; n < 2; ++n) { const f32x4 v = acc[ai][bj][m][n]; u32x2 w; w.x = pk2(v[0], v[1]); w.y = pk2(v[2], v[3]); *(u32x2*)(vt + vt_index(b, ch >> 6, ch & 63, t0 + 128 * bj + 16 * n)) = w; } }
        } else if (pn >= 2 && pn <= 5) {
            const bool isq = pn < 4; const int head = 4 * (pn - (isq ? 2 : 4)) + wc, fh = fq >> 1, fl = fq & 1;
            const float* g = isq ? qg : kg;
            f32x4 gv[2][2];
#pragma unroll
            for (int bj = 0; bj < 2; ++bj)
#pragma unroll
                for (int n = 0; n < 2; ++n) gv[bj][n] = *(const f32x4*)(g + 32 * fh + 16 * bj + 8 * fl + 4 * n);
            const float osc = isq ? 0.125f : 1.0f;
#pragma unroll
            for (int ai = 0; ai < 2; ++ai)
#pragma unroll
                for (int m = 0; m < 4; ++m) {
                    const int row = 256 * un.pm + 128 * ai + 64 * wr + 16 * m + fr, t = row & (SEQ - 1), pos = fh ? (t & 63) : (t >> 6);
                    float ss = 0.f;
#pragma unroll
                    for (int bj = 0; bj < 2; ++bj)
#pragma unroll
                        for (int n = 0; n < 2; ++n) { const f32x4 v = acc[ai][bj][m][n]; ss += (v[0] * v[0] + v[1] * v[1]) + (v[2] * v[2] + v[3] * v[3]); }
                    ss += __shfl_xor(ss, 16); ss += __shfl_xor(ss, 32);
                    const float rstd = rsqrtf(ss * (1.0f / 64.0f) + EPS) * osc;
                    f32x4 y[2][2];
#pragma unroll
                    for (int bj = 0; bj < 2; ++bj)
#pragma unroll
                        for (int n = 0; n < 2; ++n) y[bj][n] = acc[ai][bj][m][n] * rstd * gv[bj][n];
                    const size_t off = (size_t)row * NAW + head * 64 + 32 * fh + 8 * fl;
                    if (isq) {
#pragma unroll
                        for (int bj = 0; bj < 2; ++bj) { u32x4 w; w.x = pk2(y[bj][0][0], y[bj][0][1]); w.y = pk2(y[bj][0][2], y[bj][0][3]); w.z = pk2(y[bj][1][0], y[bj][1][1]); w.w = pk2(y[bj][1][2], y[bj][1][3]); *(u32x4*)(qp + off + 16 * bj) = w; }
                    }
                    f32x4 o1[2], o2[2];
#pragma unroll
                    for (int n = 0; n < 2; ++n) { const f32x4 ca = *(const f32x4*)(tab + pos * 16 + 8 * fl + 4 * n), cb = *(const f32x4*)(tab + pos * 16 + 8 * fl + 4 * n + 2);
                        const f32x4 cs = {ca[0], ca[2], cb[0], cb[2]}, sn = {ca[1], ca[3], cb[1], cb[3]};
                        o1[n] = y[0][n] * cs - y[1][n] * sn; o2[n] = y[0][n] * sn + y[1][n] * cs; }
                    bf16_t* d1p = isq ? qr + off : kr + kr_index(row >> 13, t, head, 32 * fh + 8 * fl); bf16_t* d2p = isq ? qr + off + 16 : kr + kr_index(row >> 13, t, head, 32 * fh + 16 + 8 * fl);
                    { u32x4 w; w.x = pk2(o1[0][0], o1[0][1]); w.y = pk2(o1[0][2], o1[0][3]); w.z = pk2(o1[1][0], o1[1][1]); w.w = pk2(o1[1][2], o1[1][3]); *(u32x4*)d1p = w; }
                    { u32x4 w; w.x = pk2(o2[0][0], o2[0][1]); w.y = pk2(o2[0][2], o2[0][3]); w.z = pk2(o2[1][0], o2[1][1]); w.w = pk2(o2[1][2], o2[1][3]); *(u32x4*)d2p = w; }
                }
        } else {
            bf16_t* dst; int ldd, cb; bool sig;
            if (pn < 2) { dst = u; ldd = PW; cb = 256 * pn; sig = false; } else if (pn < 12) { dst = sgp; ldd = DM; cb = 256 * (pn - 8); sig = true; } else { dst = sgn; ldd = DM; cb = 256 * (pn - 12); sig = true; }
#pragma unroll
            for (int ai = 0; ai < 2; ++ai)
#pragma unroll
                for (int m = 0; m < 4; ++m) { const int row = 256 * un.pm + 128 * ai + 64 * wr + 16 * m + fr;
#pragma unroll
                    for (int bj = 0; bj < 2; ++bj) { f32x4 v0 = acc[ai][bj][m][0], v1 = acc[ai][bj][m][1];
                        if (sig) {
#pragma unroll
                            for (int e = 0; e < 4; ++e) { v0[e] = sigmoidf_(v0[e]); v1[e] = sigmoidf_(v1[e]); } }
                        u32x4 w; w.x = pk2(v0[0], v0[1]); w.y = pk2(v0[2], v0[3]); w.z = pk2(v1[0], v1[1]); w.w = pk2(v1[2], v1[3]);
                        *(u32x4*)(dst + (size_t)row * ldd + cb + 128 * bj + 32 * wc + 8 * fq) = w; } }
        }
    }
};

struct SchedCtx {
    const char *xn, *wt; int id;
    __device__ __forceinline__ bool next(int i, pg8::Unit& u) const { if (i != 0) return false; u.pm = (id >> 2) & 1; u.pn = id & 3; u.kind = id >> 3; return true; }
    __device__ __forceinline__ const char* abase(const pg8::Unit& u) const { return xn + (size_t)(MTOK + 256 * u.pm) * (DM * 2) + u.kind * 512; }
    __device__ __forceinline__ const char* bbase(const pg8::Unit& u) const { return wt + (size_t)(1024 + 256 * u.pn) * (DM * 2) + u.kind * 512; }
};
struct EpiCtx {
    static constexpr bool AFTER_DRAIN = false, MID = false;
    float* zc;
    __device__ __forceinline__ void operator()(const acc_t& acc, const pg8::Unit& un, int wr, int wc, int fr, int fq) const {
        float* base = zc + ((size_t)un.kind * MCTX + 256 * un.pm + 64 * wr + fr) * 1024 + 256 * un.pn + 32 * wc + 4 * fq;
#pragma unroll
        for (int ai = 0; ai < 2; ++ai)
#pragma unroll
            for (int m = 0; m < 4; ++m)
#pragma unroll
                for (int bj = 0; bj < 2; ++bj)
#pragma unroll
                    for (int n = 0; n < 2; ++n) *(f32x4*)(base + (size_t)(128 * ai + 16 * m) * 1024 + 128 * bj + 16 * n) = acc[ai][bj][m][n];
    }
};
__device__ __forceinline__ void ctx_finalize(const Frame& F, const Ptrs& P) {
    const int gw = F.vcu * NWAVES + F.wave, NGW = F.G * NWAVES;
    for (int it = gw; it < MCTX * 4; it += NGW) {
        const int row = it >> 2, t = it & 3, b = row >> 8, nt = row & 255;
        f32x4 v = {0.f, 0.f, 0.f, 0.f};
#pragma unroll
        for (int kq = 0; kq < 4; ++kq) v += *(const f32x4*)(P.zc + ((size_t)kq * MCTX + row) * 1024 + 256 * t + 4 * F.lane);
        if (t < 2) {
            const int bj = F.lane >> 5, wc = (F.lane >> 3) & 3, n = (F.lane >> 2) & 1, fq = F.lane & 3, d0 = 32 * (fq >> 1) + 16 * bj + 8 * (fq & 1) + 4 * n;
            float ss = (v[0] * v[0] + v[1] * v[1]) + (v[2] * v[2] + v[3] * v[3]);
            ss += __shfl_xor(ss, 1); ss += __shfl_xor(ss, 2); ss += __shfl_xor(ss, 4); ss += __shfl_xor(ss, 32);
            const float rstd = rsqrtf(ss * (1.0f / 64.0f) + EPS);
            const f32x4 g = *(const f32x4*)(P.kg + d0), y = v * rstd * g;
            u32x2 w; w.x = pk2(y[0], y[1]); w.y = pk2(y[2], y[3]);
            *(u32x2*)(P.kc + kc_index(b, nt, 4 * t + wc, d0)) = w;
        } else {
            const int ch = 256 * (t - 2) + 4 * F.lane;
#pragma unroll
            for (int j = 0; j < 4; ++j) P.vct[vct_index(b, (ch + j) >> 6, (ch + j) & 63, nt)] = f2bf(v[j]);
        }
    }
}

struct EpiG2 {
    static constexpr bool AFTER_DRAIN = false, MID = true;
    const bf16_t *sgp, *sgn; bf16_t* mg;
    __device__ __forceinline__ void mid(acc_t& acc, const pg8::Unit& un, int wr, int wc, int fr, int fq) const {
        const size_t off0 = (size_t)(256 * un.pm + 64 * wr + fr) * DM + 256 * un.pn + 32 * wc + 8 * fq;
        const bf16_t* pp = sgp + off0; const bf16_t* np = sgn + off0;
#pragma unroll
        for (int ai = 0; ai < 2; ++ai)
#pragma unroll
            for (int m = 0; m < 4; ++m) {
#pragma unroll
                for (int bj = 0; bj < 2; ++bj) { const u32x4 a = __builtin_nontemporal_load((const u32x4*)(pp + 128 * bj)), c = *(const u32x4*)(np + 128 * bj);
                    const f32x4 p0 = {bflo(a.x), bfhi(a.x), bflo(a.y), bfhi(a.y)}, p1 = {bflo(a.z), bfhi(a.z), bflo(a.w), bfhi(a.w)};
                    const f32x4 n0 = {bflo(c.x), bfhi(c.x), bflo(c.y), bfhi(c.y)}, n1 = {bflo(c.z), bfhi(c.z), bflo(c.w), bfhi(c.w)};
#pragma unroll
                    for (int e = 0; e < 4; ++e) { acc[ai][bj][m][0][e] *= p0[e] * __builtin_amdgcn_rcpf(fmaxf(n0[e], 1e-20f)); acc[ai][bj][m][1][e] *= p1[e] * __builtin_amdgcn_rcpf(fmaxf(n1[e], 1e-20f)); } }
                pp += (m == 3 ? 80 : 16) * DM; np += (m == 3 ? 80 : 16) * DM; asm volatile("" : "+v"(pp), "+v"(np) :: "memory"); }
    }
    __device__ __forceinline__ void operator()(const acc_t& acc, const pg8::Unit& un, int wr, int wc, int fr, int fq) const {
        const size_t off0 = (size_t)(256 * un.pm + 64 * wr + fr) * DM + 256 * un.pn + 32 * wc + 8 * fq;
        const bf16_t* np = sgn + off0; const int row0 = 256 * un.pm + 64 * wr + fr, col0 = 256 * un.pn + 32 * wc + 8 * fq;
#pragma unroll
        for (int ai = 0; ai < 2; ++ai)
#pragma unroll
            for (int m = 0; m < 4; ++m) {
#pragma unroll
                for (int bj = 0; bj < 2; ++bj) { const u32x4 c = *(const u32x4*)(np + 128 * bj);
                    const f32x4 n0 = {bflo(c.x), bfhi(c.x), bflo(c.y), bfhi(c.y)}, n1 = {bflo(c.z), bfhi(c.z), bflo(c.w), bfhi(c.w)};
                    f32x4 v0, v1;
#pragma unroll
                    for (int e = 0; e < 4; ++e) { v0[e] = acc[ai][bj][m][0][e] * fmaxf(n0[e], 1e-20f); v1[e] = acc[ai][bj][m][1][e] * fmaxf(n1[e], 1e-20f); }
                    u32x4 w; w.x = pk2(v0[0], v0[1]); w.y = pk2(v0[2], v0[3]); w.z = pk2(v1[0], v1[1]); w.w = pk2(v1[2], v1[3]); *(u32x4*)(mg + t1k_index(row0 + 128 * ai + 16 * m, col0 + 128 * bj)) = w; }
                np += (m == 3 ? 80 : 16) * DM; asm volatile("" : "+v"(np) :: "memory"); }
    }
};

struct EpiG3 {
    static constexpr bool AFTER_DRAIN = false, MID = false;
    const float *x, *mod, *n2g; bf16_t* xnb; float* rowp; bf16_t* xg;
    __device__ __forceinline__ void operator()(const acc_t& acc, const pg8::Unit& un, int wr, int wc, int fr, int fq) const {
        const int b = un.pm >> 5, colb = 256 * un.pn + 32 * wc + 8 * fq;
        f32x4 g1v[2][2], gm[2][2];
#pragma unroll
        for (int bj = 0; bj < 2; ++bj)
#pragma unroll
            for (int n = 0; n < 2; ++n) { const int col = colb + 128 * bj + 4 * n; g1v[bj][n] = *(const f32x4*)(mod + b * 6144 + 2048 + col);
                gm[bj][n] = *(const f32x4*)(n2g + col) * (*(const f32x4*)(mod + b * 6144 + 4096 + col) + 1.0f); }
        const size_t off0 = (size_t)(256 * un.pm + 64 * wr + fr) * DM + colb;
#define XROW(g_) ((size_t)(128 * ((g_) >> 2) + 16 * ((g_) & 3)) * DM)
        f32x4 xp[3][2][2];
#pragma unroll
        for (int g = 0; g < 3; ++g)
#pragma unroll
            for (int bj = 0; bj < 2; ++bj) { xp[g][bj][0] = __builtin_nontemporal_load((const f32x4*)(x + off0 + XROW(g) + 128 * bj)); xp[g][bj][1] = __builtin_nontemporal_load((const f32x4*)(x + off0 + XROW(g) + 128 * bj + 4)); }
#pragma unroll
        for (int g = 0; g < 8; ++g) { const int ai = g >> 2, m = g & 3, row = 256 * un.pm + 128 * ai + 64 * wr + 16 * m + fr; float ss = 0.f;
                f32x4 v[2][2];
#pragma unroll
                for (int bj = 0; bj < 2; ++bj) { v[bj][0] = xp[g % 3][bj][0] + g1v[bj][0] * acc[ai][bj][m][0]; v[bj][1] = xp[g % 3][bj][1] + g1v[bj][1] * acc[ai][bj][m][1]; }
                if (g + 3 < 8) {
#pragma unroll
                    for (int bj = 0; bj < 2; ++bj) { xp[g % 3][bj][0] = __builtin_nontemporal_load((const f32x4*)(x + off0 + XROW(g + 3) + 128 * bj)); xp[g % 3][bj][1] = __builtin_nontemporal_load((const f32x4*)(x + off0 + XROW(g + 3) + 128 * bj + 4)); } }
#pragma unroll
                for (int bj = 0; bj < 2; ++bj) { const size_t off = (size_t)row * DM + colb + 128 * bj; const f32x4 v0 = v[bj][0], v1 = v[bj][1];
                    { u32x4 wn; wn.x = pk2(v0[0], v0[1]); wn.y = pk2(v0[2], v0[3]); wn.z = pk2(v1[0], v1[1]); wn.w = pk2(v1[2], v1[3]); *(u32x4*)(xnb + off) = wn; }
                    ss += (v0[0] * v0[0] + v0[1] * v0[1]) + (v0[2] * v0[2] + v0[3] * v0[3]) + (v1[0] * v1[0] + v1[1] * v1[1]) + (v1[2] * v1[2] + v1[3] * v1[3]);
                    const f32x4 h0 = v0 * gm[bj][0], h1 = v1 * gm[bj][1];
                    u32x4 w; w.x = pk2(h0[0], h0[1]); w.y = pk2(h0[2], h0[3]); w.z = pk2(h1[0], h1[1]); w.w = pk2(h1[2], h1[3]); *(u32x4*)(xg + t1k_index(row, colb + 128 * bj)) = w; }
                ss += __shfl_xor(ss, 16); ss += __shfl_xor(ss, 32);
                if (fq == 0) rowp[(size_t)row * 16 + un.pn * 4 + wc] = ss; }
#undef XROW
    }
};

constexpr int RSTD_OFF = MISC_OFF + 128;
struct EpiG4 {
    static constexpr bool AFTER_DRAIN = false, MID = false;
    const float* bias2; bf16_t* h; const LAS float* rs;
    __device__ __forceinline__ void operator()(const acc_t& acc, const pg8::Unit& un, int wr, int wc, int fr, int fq) const {
        const int b = un.pm >> 5, colb = 256 * un.pn + 32 * wc + 8 * fq;
        f32x4 bv[2][2];
#pragma unroll
        for (int bj = 0; bj < 2; ++bj)
#pragma unroll
            for (int n = 0; n < 2; ++n) bv[bj][n] = *(const f32x4*)(bias2 + b * FF + colb + 128 * bj + 4 * n);
#pragma unroll
        for (int ai = 0; ai < 2; ++ai)
#pragma unroll
            for (int m = 0; m < 4; ++m) { const int rt = 128 * ai + 64 * wr + 16 * m + fr, row = 256 * un.pm + rt; const float rstd = rs[un.kind * 256 + rt];
#pragma unroll
                for (int bj = 0; bj < 2; ++bj) { f32x4 v0 = acc[ai][bj][m][0] * rstd + bv[bj][0], v1 = acc[ai][bj][m][1] * rstd + bv[bj][1];
#pragma unroll
                    for (int e = 0; e < 4; ++e) { const float a0 = fmaxf(v0[e], 0.f), a1 = fmaxf(v1[e], 0.f); v0[e] = a0 * a0; v1[e] = a1 * a1; }
                    u32x4 w; w.x = pk2(v0[0], v0[1]); w.y = pk2(v0[2], v0[3]); w.z = pk2(v1[0], v1[1]); w.w = pk2(v1[2], v1[3]);
                    *(u32x4*)(h + h_index(row, colb + 128 * bj)) = w; } }
    }
};

struct EpiG5 {
    static constexpr bool AFTER_DRAIN = false, MID = false;
    const float* mod; const bf16_t* xnb; float* out;
    __device__ __forceinline__ void operator()(const acc_t& acc, const pg8::Unit& un, int wr, int wc, int fr, int fq) const {
        const int b = un.pm >> 5, colb = 256 * un.pn + 32 * wc + 8 * fq;
        f32x4 g2v[2][2];
#pragma unroll
        for (int bj = 0; bj < 2; ++bj)
#pragma unroll
            for (int n = 0; n < 2; ++n) g2v[bj][n] = *(const f32x4*)(mod + b * 6144 + 5120 + colb + 128 * bj + 4 * n);
        const size_t off0 = (size_t)(256 * un.pm + 64 * wr + fr) * DM + colb;
        u32x4 xp[8][2];
#pragma unroll
        for (int g = 0; g < 8; ++g)
#pragma unroll
            for (int bj = 0; bj < 2; ++bj) xp[g][bj] = __builtin_nontemporal_load((const u32x4*)(xnb + off0 + (size_t)(128 * (g >> 2) + 16 * (g & 3)) * DM + 128 * bj));
#pragma unroll
        for (int ai = 0; ai < 2; ++ai)
#pragma unroll
            for (int m = 0; m < 4; ++m) {
#pragma unroll
                for (int bj = 0; bj < 2; ++bj) { const u32x4 xw = xp[ai * 4 + m][bj];
                    const f32x4 x0 = {bflo(xw.x), bfhi(xw.x), bflo(xw.y), bfhi(xw.y)}, x1 = {bflo(xw.z), bfhi(xw.z), bflo(xw.w), bfhi(xw.w)};
                    const f32x4 v0 = x0 + g2v[bj][0] * acc[ai][bj][m][0], v1 = x1 + g2v[bj][1] * acc[ai][bj][m][1];
                    float* o = out + off0 + (size_t)(128 * ai + 16 * m) * DM + 128 * bj; __builtin_nontemporal_store(v0, (f32x4*)o); __builtin_nontemporal_store(v1, (f32x4*)(o + 4)); } }
    }
};

#define MFMA16(a, b, c) __builtin_amdgcn_mfma_f32_16x16x32_bf16((a), (b), (c), 0, 0, 0)
constexpr int RPB_LD = 56;
#define SB() __builtin_amdgcn_sched_barrier(0)
struct AttnRsrc { __amdgpu_buffer_rsrc_t qr, qp; };
constexpr int ATT_BUF = 65536, ATT_NSTAGE = 16;
__device__ __forceinline__ void attn_dma(const Frame& F, const Ptrs& P, LAS unsigned char* buf, int b, int R0, int h, int kind) {
    if (kind < 3) {
#pragma unroll
        for (int i = 0; i < 6; ++i) { const int p = F.wave * 6 + i, ten = p / 24, row = min(R0 + 3 * kind + (p % 24) / 8, NROWS - 1), pc = p & 7;
            const bf16_t* src = (ten ? P.vt : P.kr) + (size_t)((b * NROWS + row) * NH + h) * 4096 + pc * 512 + F.lane * 8;
            __builtin_amdgcn_global_load_lds((const unsigned*)src, (LAS unsigned*)(buf + p * 1024), 16, 0, 0); }
    } else {
#pragma unroll
        for (int i = 0; i < 8; ++i) { const int p = F.wave * 8 + i;
            const bf16_t* src = ((p >> 5) ? P.vct : P.kc) + (size_t)(b * NH + h) * 16384 + (p & 31) * 512 + F.lane * 8;
            __builtin_amdgcn_global_load_lds((const unsigned*)src, (LAS unsigned*)(buf + p * 1024), 16, 0, 0); }
    }
}
__device__ __forceinline__ void attn_phase(const Frame& F, const Ptrs& P, int variant) {
    AttnRsrc R;
    R.qr = __builtin_amdgcn_make_buffer_rsrc((void*)P.qr, (short)0, MTOK * NAW * 2, 0x00020000); R.qp = __builtin_amdgcn_make_buffer_rsrc((void*)P.qp, (short)0, MTOK * NAW * 2, 0x00020000);
    LAS float* rl = (LAS float*)(F.lds + RSTD_OFF);
    for (int i = F.tid; i < NH * 15 * RPB_LD; i += 512) { const int hr = i / RPB_LD, cc = i % RPB_LD - 8; rl[i] = (cc >= 0 && cc < 31) ? P.rpb[hr * 31 + cc] : 0.f; }
    __syncthreads();
    const int lane = F.lane, qi = lane & 15, fq = lane >> 4, rs = F.wave >> 2, jb = F.wave & 3;
    const float LOG2E = 1.4426950408889634f;
    const f32x4 zero = {0.f, 0.f, 0.f, 0.f};
#define LDF(rs_, so, vo) __builtin_bit_cast(bf16x8, __builtin_amdgcn_raw_buffer_load_b128((rs_), (int)(vo), (int)(so), 2))
    for (int item = F.vcu; item < NB * NROWS; item += F.G) {
        const int b = item >> 7, rp = (item >> 1) & 63, hh = item & 1, r = 2 * rp;
        if (variant != 2) {
            const int g = F.wave & 3, t0 = (r + hh) * 64 + (F.wave >> 2) * 32 + (lane >> 4) * 8, ch = 16 * g + (lane & 15);
            if (g == 0) pool_seg8<2>(P, b, t0, ch); else if (g == 1) pool_seg8<4>(P, b, t0, ch); else if (g == 2) pool_seg8<8>(P, b, t0, ch); else pool_seg8<16>(P, b, t0, ch);
        }
        if (variant == 1) continue;
        const int R0 = min(max(r - 4, 0), NROWS - 8), rq = r + rs, w0 = min(max(rq - 4, 0), NROWS - 8) - R0;
        const int c = 16 * jb + qi, kc0 = min(max(16 * jb - 8, 0), 32), c0 = min(max(c - 8, 0), GW - 16), kq0 = kc0 + 8 * fq - c0;
        const unsigned qoff = (unsigned)(qi * NAW + 8 * fq) * 2u, ooff = (unsigned)(qi * DM + 4 * fq) * 2u;
        const int eq0 = (kc0 >> 3) + (qi >> 2);
        const unsigned kl = (unsigned)((fq * 4 + (eq0 >> 2)) * 256 + ((qi & 3) * 4 + (eq0 & 3)) * 16);
        const unsigned vl = (unsigned)(((kc0 >> 3) + fq) * 1024 + qi * 16);
        const unsigned cl = (unsigned)lane * 16u;
        bf16x8 qr0, qr1, qp0, qp1; float m = -INFINITY, l = 0.f; f32x4 o[4] = {zero, zero, zero, zero};
        { const unsigned qS = (unsigned)(((b * SEQ + rq * 64 + 16 * jb) * NAW + (4 * hh) * 64) * 2);
          qr0 = LDF(R.qr, qS, qoff); qr1 = LDF(R.qr, qS + 64u, qoff); qp0 = LDF(R.qp, qS, qoff); qp1 = LDF(R.qp, qS + 64u, qoff); }
        attn_dma(F, P, F.lds, b, R0, 4 * hh, 0);
#define LB(p) (*(const LAS bf16x8*)(p))
#define STAGE_SOFTMAX(NC) do { \
            float cm_ = -INFINITY; \
            _Pragma("unroll") for (int c_ = 0; c_ < NC; ++c_) _Pragma("unroll") for (int e_ = 0; e_ < 8; ++e_) cm_ = fmaxf(cm_, sc[c_][e_]); \
            cm_ = fmaxf(cm_, __shfl_xor(cm_, 16)); cm_ = fmaxf(cm_, __shfl_xor(cm_, 32)); \
            const float mn_ = fmaxf(m, cm_), al_ = __builtin_amdgcn_exp2f((m - mn_) * LOG2E), ml_ = mn_ * LOG2E; m = mn_; \
            float ps_ = 0.f; \
            _Pragma("unroll") for (int c_ = 0; c_ < NC; ++c_) { \
                _Pragma("unroll") for (int e_ = 0; e_ < 8; ++e_) { sc[c_][e_] = __builtin_amdgcn_exp2f(sc[c_][e_] * LOG2E - ml_); ps_ += sc[c_][e_]; } \
                u32x4 pw_; pw_.x = pk2(sc[c_][0], sc[c_][1]); pw_.y = pk2(sc[c_][2], sc[c_][3]); pw_.z = pk2(sc[c_][4], sc[c_][5]); pw_.w = pk2(sc[c_][6], sc[c_][7]); pa[c_] = __builtin_bit_cast(bf16x8, pw_); } \
            l = l * al_ + ps_; \
            _Pragma("unroll") for (int db_ = 0; db_ < 4; ++db_) o[db_] = o[db_] * al_; } while (0)
        for (int t = 0; t < ATT_NSTAGE; ++t) {
            const int hi = t >> 2, kind = t & 3, h = 4 * hh + hi;
            LAS unsigned char* buf = F.lds + (t & 1) * ATT_BUF;
            __syncthreads();
            bf16x8 nq0, nq1, np0, np1;
            if (kind == 3 && hi < 3) { const unsigned qS = (unsigned)(((b * SEQ + rq * 64 + 16 * jb) * NAW + (h + 1) * 64) * 2);
                nq0 = LDF(R.qr, qS, qoff); nq1 = LDF(R.qr, qS + 64u, qoff); np0 = LDF(R.qp, qS, qoff); np1 = LDF(R.qp, qS + 64u, qoff); }
            if (t + 1 < ATT_NSTAGE) attn_dma(F, P, F.lds + ((t + 1) & 1) * ATT_BUF, b, R0, 4 * hh + ((t + 1) >> 2), (t + 1) & 3);
            if (kind < 3) {
                float sc[3][8]; bf16x8 pa[3];
#pragma unroll
                for (int j = 0; j < 3; ++j) { const int wr = 3 * kind + j - w0;
                    if (wr >= 0 && wr < 8) {
                        const LAS unsigned char* kb = buf + j * 8192 + kl;
                        const LAS float* bp = rl + h * 15 * RPB_LD + (R0 + w0 - rq + 7 + wr) * RPB_LD + (kc0 + 8 * fq - c + 23);
                        float bs[8];
#pragma unroll
                        for (int e = 0; e < 8; ++e) bs[e] = bp[e];
                        f32x4 s0 = MFMA16(LB(kb), qr0, zero); s0 = MFMA16(LB(kb + 4096), qr1, s0);
                        f32x4 s1 = MFMA16(LB(kb + 512), qr0, zero); s1 = MFMA16(LB(kb + 4096 + 512), qr1, s1);
#pragma unroll
                        for (int e = 0; e < 8; ++e) { const bool valid = (unsigned)(kq0 + e) < 16u; sc[j][e] = valid ? (e < 4 ? s0[e & 3] : s1[e & 3]) + bs[e] : -INFINITY; }
                    } else {
#pragma unroll
                        for (int e = 0; e < 8; ++e) sc[j][e] = -INFINITY; } }
                STAGE_SOFTMAX(3);
#pragma unroll
                for (int j = 0; j < 3; ++j) { const int wr = 3 * kind + j - w0;
                    if (wr >= 0 && wr < 8) { const LAS unsigned char* vb = buf + 24576 + j * 8192 + vl;
#pragma unroll
                        for (int db = 0; db < 4; ++db) o[db] = MFMA16(LB(vb + db * 256), pa[j], o[db]); } }
            } else {
                float sc[8][8]; bf16x8 pa[8];
#pragma unroll
                for (int g = 0; g < 8; ++g) { const LAS unsigned char* kb = buf + g * 4096 + cl;
                    f32x4 s0 = MFMA16(LB(kb), qp0, zero); s0 = MFMA16(LB(kb + 1024), qp1, s0);
                    f32x4 s1 = MFMA16(LB(kb + 2048), qp0, zero); s1 = MFMA16(LB(kb + 3072), qp1, s1);
#pragma unroll
                    for (int e = 0; e < 8; ++e) sc[g][e] = (e < 4 ? s0[e & 3] : s1[e & 3]); }
                STAGE_SOFTMAX(8);
#pragma unroll
                for (int g = 0; g < 8; ++g) { const LAS unsigned char* vb = buf + 32768 + g * 4096 + cl;
#pragma unroll
                    for (int db = 0; db < 4; ++db) o[db] = MFMA16(LB(vb + db * 1024), pa[g], o[db]); }
                float lt = l; lt += __shfl_xor(lt, 16); lt += __shfl_xor(lt, 32);
                const float il = 1.0f / lt;
                char* oU = (char*)((variant >= 5 ? P.xn : P.dn) + ((size_t)b * SEQ + rq * 64 + 16 * jb) * DM + 512 + h * 64);
#pragma unroll
                for (int db = 0; db < 4; ++db) { const f32x4 ov = o[db] * il; u32x2 w; w.x = pk2(ov[0], ov[1]); w.y = pk2(ov[2], ov[3]); *(u32x2*)(oU + 32 * db + ooff) = w; o[db] = zero; }
                m = -INFINITY; l = 0.f;
                if (hi < 3) { qr0 = nq0; qr1 = nq1; qp0 = np0; qp1 = np1; }
            }
        }
        __syncthreads();
#undef STAGE_SOFTMAX
#undef LB
    }
#undef LDF
}

__global__ void __launch_bounds__(NWAVES * 64, 2) mk_fwd(Args args) {
    extern __shared__ __attribute__((aligned(16))) unsigned char lds_raw[];
    Frame F; F.lds = (LAS unsigned char*)lds_raw;
    volatile LAS unsigned* MISC = (volatile LAS unsigned*)(F.lds + MISC_OFF);
    F.tid = threadIdx.x; F.lane = F.tid & 63; F.wave = __builtin_amdgcn_readfirstlane(F.tid >> 6);
    F.G = gridDim.x; { const int bx = blockIdx.x; F.vcu = (F.G % 8 == 0) ? (bx % 8) * (F.G / 8) + bx / 8 : bx; }
    const Ptrs P = make_ptrs(args);
    for (int u = F.tid; u < (LDS_BYTES - LDSCTL_OFF) / 4; u += NWAVES * 64) ((LAS unsigned*)(F.lds + LDSCTL_OFF))[u] = 0u;
    __syncthreads();
    XcdBarrier bar; bar.bar = (unsigned*)(P.ws + WS_CTL) + CW_BAR + args.li * XCD_BAR_WORDS; bar.x = 0; bar.st = nullptr;
#if ONE_LAUNCH
    bar = xcd_barrier_post((unsigned*)(P.ws + WS_CTL) + CW_BAR + args.li * XCD_BAR_WORDS, MISC + 8);
#define GRID_BAR() xcd_barrier(bar)
#define SHADOW_BAR(k, work) do { if (BOTH(k)) xcd_barrier_shadow(bar, [&]() { work; }); else { __syncthreads(); if (threadIdx.x >= 64) { work; } __syncthreads(); } } while (0)
#else
#define GRID_BAR() do { } while (0)
#define SHADOW_BAR(k, work) do { __syncthreads(); if (threadIdx.x >= 64) { work; } __syncthreads(); } while (0)
#endif
    const int lo = args.ph_lo, hi = args.ph_hi;
#ifndef PH_MASK
#define PH_MASK 0xFF
#endif
#define IN(k) (((PH_MASK >> (k)) & 1) && lo <= (k) && (k) < hi)
#define BOTH(k) (IN(k) && IN((k) + 1))
    if (IN(0)) { phase0(F, P, args.pad);   }
    if (IN(1)) {
        phase1(F, P);
        if (F.G > 32 && F.vcu < 32) {
            SchedCtx S{(const char*)P.xn, (const char*)P.wtin, F.vcu};
            EpiCtx E{P.zc};
            pg8::gemm_phase<EpiCtx, SchedCtx, true, true>(F.lds, pg8::Gemm{DM, 256}, S, E);
        }
        SHADOW_BAR(1, late_tiles(F, P, 0, 1792, 7));
    }
    if (IN(2)) {
        if (F.G <= 32) ctx_kv(F, P); else ctx_finalize(F, P);
        SchedG1 S{(const char*)P.xn, (const char*)P.wtin, F.G, (int)blockIdx.x};
        EpiG1 E{P.u, P.qr, P.qp, P.kr, P.vt, P.sgp, P.sgn, P.qg, P.kg, P.tab, args.pad};
        pg8::gemm_phase<EpiG1, SchedG1, true, true>(F.lds, pg8::Gemm{DM, DM}, S, E);
        SHADOW_BAR(2, (late_tiles(F, P, 1792, 512, 2), fold_items(F, P)));
    }
    if (IN(3)) {
        attn_phase(F, P, args.pad);
        SHADOW_BAR(3, late_tiles(F, P, 2304, 1536, 6));
    }
    if (IN(4)) {
        SchedStd S{(const char*)P.dn, (const char*)P.wtbr, MTOK / 256, DM / 256, DM * 2, F.G, (int)blockIdx.x};
        EpiG2 E{P.sgp, P.sgn, P.mg};
        pg8::gemm_phase<EpiG2, SchedStd, true, true>(F.lds, pg8::Gemm{DM, DM}, S, E);
        SHADOW_BAR(4, bias2_items(F, P, F.vcu * 7 + F.wave - 1, F.G * 7));
    }
    if (IN(5)) {
        SchedStd S{(const char*)P.mg, (const char*)P.wtout, MTOK / 256, DM / 256, DM * 2, F.G, (int)blockIdx.x};
        EpiG3 E{P.x, P.mod, P.n2g, P.xnb, P.rowp, P.xg};
        pg8::gemm_phase<EpiG3, SchedStd, true, true, true>(F.lds, pg8::Gemm{DM, DM}, S, E);
        SHADOW_BAR(5, late_tiles(F, P, 3840, 1024, 4));
    }
    if (IN(6)) {
        SchedStd S{(const char*)P.xg, (const char*)P.wt1, MTOK / 256, FF / 256, DM * 2, F.G, (int)blockIdx.x};
        LAS float* rs = (LAS float*)(F.lds + RSTD_OFF);
        { pg8::Unit un;
          for (int i = 0; i < 12 && S.next(i, un); ++i)
              for (int rt = F.tid; rt < 256; rt += NWAVES * 64) { const float* rp = P.rowp + (size_t)(256 * un.pm + rt) * 16; float sq = 0.f;
#pragma unroll
                  for (int q = 0; q < 4; ++q) { const f32x4 v = *(const f32x4*)(rp + 4 * q); sq += (v.x + v.y) + (v.z + v.w); }
                  rs[i * 256 + rt] = rsqrtf(sq * (1.0f / DM) + EPS); }
          __syncthreads(); }
        EpiG4 E{P.bias2, P.h, rs};
        pg8::gemm_phase<EpiG4, SchedStd, true, true, true>(F.lds, pg8::Gemm{DM, DM}, S, E);
        if (BOTH(6)) GRID_BAR();
    }
    if (IN(7)) {
        SchedStd S{(const char*)P.h, (const char*)P.wt2, MTOK / 256, DM / 256, FF * 2, F.G, (int)blockIdx.x};
        EpiG5 E{P.mod, P.xnb, P.out};
        pg8::gemm_phase<EpiG5, SchedStd, true, true, true>(F.lds, pg8::Gemm{FF, FF}, S, E);
    }
#undef IN
#undef BOTH
}

extern "C" void kernel_launch(void* const* d_in, const int* in_sizes, int n_in, void* d_out, int out_size, void* d_ws, size_t ws_size, hipStream_t stream) {
    static int grid = 0;
    if (grid == 0) {
        if (n_in != 19 || in_sizes[0] != MTOK * DM || out_size != MTOK * DM || ws_size < WS_END) { fprintf(stderr, "kernel_launch: unexpected problem shape / workspace (%d inputs, ws %zu)\n", n_in, ws_size); grid = -1; return; }
        int dev = 0, cus = 0, per_cu = 0;
        if (hipGetDevice(&dev) != hipSuccess || hipDeviceGetAttribute(&cus, hipDeviceAttributeMultiprocessorCount, dev) != hipSuccess) { grid = -1; return; }
        if (hipFuncSetAttribute((const void*)mk_fwd, hipFuncAttributeMaxDynamicSharedMemorySize, LDS_BYTES) != hipSuccess) { fprintf(stderr, "kernel_launch: hipFuncSetAttribute failed\n"); grid = -1; return; }
        if (hipOccupancyMaxActiveBlocksPerMultiprocessor(&per_cu, (const void*)mk_fwd, NWAVES * 64, LDS_BYTES) != hipSuccess || per_cu < 1) { fprintf(stderr, "kernel_launch: occupancy query reports %d workgroups per CU\n", per_cu); (void)hipGetLastError(); grid = -1; return; }
        grid = cus;
    }
    if (grid < 0) return;
    (void)hipMemsetAsync((char*)d_ws + WS_CTL, 0, CTL_ZERO_BYTES, stream);
    Args a{};
    for (int i = 0; i < 19; ++i) a.in[i] = (const float*)d_in[i];
    a.out = (float*)d_out; a.ws = (unsigned char*)d_ws;
#if ONE_LAUNCH
#if DUP_PHASE >= 0
#if DUP_MODE == 3
    a.ph_lo = 0; a.ph_hi = DUP_PHASE + 1; a.li = 1; a.pad = DUP_VARIANT;
    hipLaunchKernelGGL(mk_fwd, dim3(grid), dim3(NWAVES * 64), LDS_BYTES, stream, a);
    a.ph_lo = 0; a.ph_hi = NPH; a.li = 0; a.pad = 0;
    hipLaunchKernelGGL(mk_fwd, dim3(grid), dim3(NWAVES * 64), LDS_BYTES, stream, a);
    return;
#elif DUP_MODE == 2
    a.ph_lo = 0; a.ph_hi = NPH; a.li = 0;
#else
    a.ph_lo = 0; a.ph_hi = DUP_PHASE + 1; a.li = 0;
#endif
    hipLaunchKernelGGL(mk_fwd, dim3(grid), dim3(NWAVES * 64), LDS_BYTES, stream, a);
    a.ph_lo = DUP_PHASE; a.ph_hi = NPH; a.li = 1; a.pad = DUP_VARIANT;
    hipLaunchKernelGGL(mk_fwd, dim3(grid), dim3(NWAVES * 64), LDS_BYTES, stream, a);
#else
    a.ph_lo = 0; a.ph_hi = NPH;
    hipLaunchKernelGGL(mk_fwd, dim3(grid), dim3(NWAVES * 64), LDS_BYTES, stream, a);
#endif
#else
    for (int ph = 0; ph < NPH; ++ph) {
        a.ph_lo = ph; a.ph_hi = ph + 1;
        if ((NAIVE_MASK >> ph) & 1) {
            switch (ph) {
                case 2: hipLaunchKernelGGL(naive_g1, dim3(1024), dim3(512), 0, stream, a); break;
                case 3: hipLaunchKernelGGL(naive_attn, dim3(2048), dim3(256), 0, stream, a); break;
                case 4: hipLaunchKernelGGL(naive_g2, dim3(1024), dim3(512), 0, stream, a); break;
                case 5: hipLaunchKernelGGL(naive_g3, dim3(1024), dim3(512), 0, stream, a); break;
                case 6: hipLaunchKernelGGL(naive_g4, dim3(1024), dim3(512), 0, stream, a); break;
                case 7: hipLaunchKernelGGL(naive_g5, dim3(1024), dim3(512), 0, stream, a); break;
                default: break;
            }
        } else {
            hipLaunchKernelGGL(mk_fwd, dim3(grid), dim3(NWAVES * 64), LDS_BYTES, stream, a);
            if (ph == DUP_PHASE) hipLaunchKernelGGL(mk_fwd, dim3(grid), dim3(NWAVES * 64), LDS_BYTES, stream, a);
        }
    }
#endif
}
```

```cpp
#include <hip/hip_runtime.h>
#include <cstdio>
#include <cstdint>

#ifndef ONE_LAUNCH
#define ONE_LAUNCH 1
#endif
#ifndef DUP_PHASE
#define DUP_PHASE -1
#endif
#ifndef DUP_MODE
#define DUP_MODE 1
#endif
#ifndef DUP_VARIANT
#define DUP_VARIANT 0
#endif
#ifndef NAIVE_MASK
#define NAIVE_MASK 0x00
#endif

#define GAS __attribute__((address_space(1)))
#define LAS __attribute__((address_space(3)))
typedef unsigned short bf16_t;
typedef short bf16x8 __attribute__((ext_vector_type(8)));
typedef float f32x2 __attribute__((ext_vector_type(2)));
typedef float f32x4 __attribute__((ext_vector_type(4)));
typedef float f32x16 __attribute__((ext_vector_type(16)));
typedef unsigned u32x2 __attribute__((ext_vector_type(2)));
typedef unsigned u32x4 __attribute__((ext_vector_type(4)));
typedef __bf16 bf16x2_t __attribute__((ext_vector_type(2)));

constexpr int NB = 2, SEQ = 8192, DM = 1024, MTOK = NB * SEQ, CTXL = 256, MCTX = NB * CTXL, FF = 4096, INW = 4096;
constexpr int NH = 8, HD = 64, NAW = 512, PW = 512, GW = 64, NROWS = SEQ / GW;
constexpr float EPS = 1e-6f;
constexpr int NPH = 8;

constexpr size_t MiB = 1u << 20;
constexpr size_t WS_CTL = 0, CTL_ZERO_BYTES = 128 * 1024;
constexpr size_t WS_SMALL = 1 * MiB;
constexpr size_t OFF_MODP = 0;
constexpr size_t OFF_MOD = 294912;
constexpr size_t OFF_TAB = OFF_MOD + 73728;
constexpr size_t OFF_BIAS2 = OFF_TAB + 16384;
constexpr size_t OFF_ROWP = OFF_BIAS2 + 32768;
static_assert(OFF_ROWP + 262144 <= MiB, "small region");
constexpr size_t WS_WTIN = 2 * MiB, WS_WTBR = 11 * MiB, WS_WTOUT = 13 * MiB, WS_WT1 = 15 * MiB, WS_WT2 = 23 * MiB;
constexpr size_t WS_KC = 31 * MiB, WS_VCT = 31 * MiB + 512 * 1024;
constexpr size_t WS_ROWP = 32 * MiB;
constexpr size_t WS_XN = 34 * MiB;
constexpr size_t WS_U = 67 * MiB, WS_QR = 83 * MiB, WS_QP = 99 * MiB, WS_KR = 115 * MiB, WS_VT = 131 * MiB, WS_SGP = 147 * MiB, WS_SGN = 179 * MiB, WS_DN = 211 * MiB;
constexpr size_t WS_ZC = 243 * MiB;
constexpr size_t WS_MG = 34 * MiB, WS_TMP = 67 * MiB, WS_XG = 67 * MiB, WS_H = 128 * MiB, WS_END = 256 * MiB;

__device__ __forceinline__ unsigned pk2(float lo, float hi) { f32x2 v = {lo, hi}; bf16x2_t b = __builtin_convertvector(v, bf16x2_t); return __builtin_bit_cast(unsigned, b); }
__device__ __forceinline__ bf16_t f2bf(float f) { return (bf16_t)(pk2(f, 0.f) & 0xffffu); }
__device__ __forceinline__ float bf2f(bf16_t h) { return __uint_as_float(((unsigned)h) << 16); }
__device__ __forceinline__ float bflo(unsigned w) { return __uint_as_float(w << 16); }
__device__ __forceinline__ float bfhi(unsigned w) { return __uint_as_float(w & 0xffff0000u); }
__device__ __forceinline__ float sigmoidf_(float x) { return __builtin_amdgcn_rcpf(1.0f + __expf(-x)); }
__device__ __forceinline__ float siluf_(float x) { return x / (1.0f + __expf(-x)); }
__device__ __forceinline__ float wave_sum(float v) {
#pragma unroll
    for (int o = 1; o < 64; o <<= 1) v += __shfl_xor(v, o);
    return v;
}
#define LDS_WAIT() asm volatile("s_waitcnt lgkmcnt(0)" ::: "memory")
#define VM_WAIT() asm volatile("s_waitcnt vmcnt(0)" ::: "memory")
__device__ __forceinline__ float sum_x16_x32(float v) {
    { const unsigned u = __float_as_uint(v); const auto r = __builtin_amdgcn_permlane16_swap(u, u, false, false); v = __uint_as_float(r[0]) + __uint_as_float(r[1]); }
    { const unsigned u = __float_as_uint(v); const auto r = __builtin_amdgcn_permlane32_swap(u, u, false, false); v = __uint_as_float(r[0]) + __uint_as_float(r[1]); }
    return v;
}
__device__ __forceinline__ float max_x16_x32(float v) {
    { const unsigned u = __float_as_uint(v); const auto r = __builtin_amdgcn_permlane16_swap(u, u, false, false); v = fmaxf(__uint_as_float(r[0]), __uint_as_float(r[1])); }
    { const unsigned u = __float_as_uint(v); const auto r = __builtin_amdgcn_permlane32_swap(u, u, false, false); v = fmaxf(__uint_as_float(r[0]), __uint_as_float(r[1])); }
    return v;
}

__host__ __device__ __forceinline__ int inv_std(int a) { return (a & 0xE3) | ((a & 0x04) << 2) | ((a & 0x18) >> 1); }
__host__ __device__ __forceinline__ int inv_head(int a) { const int wc = a >> 6, fh = (a >> 5) & 1, bj = (a >> 4) & 1, fl = (a >> 3) & 1, n = (a >> 2) & 1, j = a & 3; return (bj << 7) | (wc << 5) | (n << 4) | (fh << 3) | (fl << 2) | j; }
__host__ __device__ __forceinline__ int fwd_std(int p) { return (p & 0xE3) | ((p & 0x0C) << 1) | ((p & 0x10) >> 2); }
__host__ __device__ __forceinline__ int wrow_std(int n) { return (n & ~255) | inv_std(n & 255); }
__host__ __device__ __forceinline__ int wrow_in(int n) { const int t = n >> 8, a = n & 255; const int p = (t >= 2 && t <= 5) ? inv_head(a) : ((t == 6 || t == 7) ? a : inv_std(a)); return (t << 8) | p; }

namespace pg8 {
constexpr int BM = 256, BK = 64, HALF = 128, HTB = HALF * BK * 2, STAGE_BYTES = 8 * HTB, NXCD = 8, WGM = 8;
__host__ __device__ __forceinline__ int lds_byte(int r, int c) { const int st = (r >> 4) * 2 + (c >> 5), rr = r & 15, cc = c & 31, ob = rr * 64 + cc * 2; return st * 1024 + (ob ^ (((ob >> 9) & 1) << 5)); }
__host__ __device__ __forceinline__ void stage_rc(int b, int& R, int& C) { const int st = b / 1024, sb = b % 1024, swz = sb ^ (((sb >> 9) & 1) << 5); R = (st >> 1) * 16 + swz / 64; C = (st & 1) * 32 + (swz % 64) / 2; }

struct Unit { int pm, pn, kind; };
struct Gemm { int ld, K; };

__device__ __forceinline__ bool static_tile(int nM, int nN, int G, int c, int i, int& pm, int& pn) {
    const int nwg = nM * nN; const long L = (long)i * G + c; if (L >= nwg) return false;
    int wgid = (int)L; { const int q = nwg / NXCD, r = nwg % NXCD, xcd = wgid % NXCD, off = wgid / NXCD; wgid = (xcd < r ? xcd * (q + 1) : r * (q + 1) + (xcd - r) * q) + off; }
    const int nig = WGM * nN, gid = wgid / nig, fm = gid * WGM, gsz = (nM - fm) < WGM ? (nM - fm) : WGM;
    pm = fm + ((wgid % nig) % gsz); pn = (wgid % nig) / gsz; return true;
}

template <class Epi, class Sched, bool ALIGN_EPI, bool SP2, bool ATILED = false>
__device__ __forceinline__ void gemm_phase(LAS unsigned char* lds, const Gemm g, const Sched& S, const Epi& E) {
    const int tid = threadIdx.x, wid = __builtin_amdgcn_readfirstlane(tid >> 6), lane = tid & 63, wr = wid >> 2, wc = wid & 3, fr = lane & 15, fq = lane >> 4;
    const int K = g.K, nt = K / BK, ld = g.ld;
    unsigned voffA[2], voffB[2];
#pragma unroll
    for (int i = 0; i < 2; ++i) { int R, C; stage_rc(tid * 16 + i * 8192, R, C); voffB[i] = (unsigned)(R * ld + C) * 2u; voffA[i] = ATILED ? (unsigned)(R * BK + C) * 2u : voffB[i]; }
    const size_t kstepB = (size_t)(BK * 2), kstepA = ATILED ? (size_t)(BM * BK * 2) : kstepB;
    const size_t hstepB = (size_t)HALF * ld * 2, hstepA = ATILED ? (size_t)(HALF * BK * 2) : hstepB;
    const unsigned ldsw = (unsigned)wid * 1024u;
    const int aoff = lds_byte(wr * 64 + fr, fq * 8), boff = lds_byte(wc * 32 + fr, fq * 8);
#define PG8_SA(b, h) (((b) * 2 + (h)) * HTB)
#define PG8_SB(b, h) ((4 + (b) * 2 + (h)) * HTB)
#define PG8_STAGEX(bufoff, gbase, vo) do { _Pragma("unroll") for (int _i = 0; _i < 2; ++_i) \
        __builtin_amdgcn_global_load_lds((const unsigned*)((const char*)(gbase) + vo[_i]), (LAS unsigned*)(lds + (bufoff) + ldsw + _i * 8192), 16, 0, 0); } while (0)
#define PG8_STAGEA(bufoff, gbase) PG8_STAGEX(bufoff, gbase, voffA)
#define PG8_STAGEB(bufoff, gbase) PG8_STAGEX(bufoff, gbase, voffB)
#define PG8_LDA(dst, b, h) do { _Pragma("unroll") for (int m = 0; m < 4; ++m) _Pragma("unroll") for (int k = 0; k < 2; ++k) dst[m][k] = *(const LAS bf16x8*)(lds + PG8_SA(b, h) + aoff + m * 2048 + k * 1024); } while (0)
#define PG8_LDB(dst, b, h) do { _Pragma("unroll") for (int n = 0; n < 2; ++n) _Pragma("unroll") for (int k = 0; k < 2; ++k) dst[n][k] = *(const LAS bf16x8*)(lds + PG8_SB(b, h) + boff + n * 2048 + k * 1024); } while (0)
#define PG8_MMA(ai, bj, At, Bt) do { __builtin_amdgcn_s_setprio(1); _Pragma("unroll") for (int m = 0; m < 4; ++m) _Pragma("unroll") for (int n = 0; n < 2; ++n) _Pragma("unroll") for (int k = 0; k < 2; ++k) \
        acc[ai][bj][m][n] = __builtin_amdgcn_mfma_f32_16x16x32_bf16(Bt[n][k], At[m][k], acc[ai][bj][m][n], 0, 0, 0); __builtin_amdgcn_s_setprio(0); } while (0)
#define PG8_WAIT_V(n) asm volatile("s_waitcnt vmcnt(" #n ")" ::: "memory")
#define PG8_WAIT_L(n) asm volatile("s_waitcnt lgkmcnt(" #n ")" ::: "memory")
#define PG8_BAR __builtin_amdgcn_s_barrier()
#define PG8_SCHED __builtin_amdgcn_sched_barrier(0)
    Unit cur, nxt; int ui = 0;
    if (!S.next(0, cur)) return;
    f32x4 acc[2][2][4][2];
#pragma unroll
    for (int a = 0; a < 2; ++a)
#pragma unroll
        for (int b = 0; b < 2; ++b)
#pragma unroll
            for (int m = 0; m < 4; ++m)
#pragma unroll
                for (int n = 0; n < 2; ++n) acc[a][b][m][n] = (f32x4){0.f, 0.f, 0.f, 0.f};
    bf16x8 At[4][2], B0[2][2], B1[2][2];
    const char* cA = S.abase(cur); const char* cB = S.bbase(cur);
    if constexpr (SP2) {
        PG8_STAGEB(PG8_SB(0, 0), cB); PG8_STAGEB(PG8_SB(0, 1), cB + hstepB); PG8_STAGEA(PG8_SA(0, 0), cA); PG8_STAGEA(PG8_SA(0, 1), cA + hstepA);
        if (wr == 1) PG8_BAR;
        PG8_WAIT_V(2); PG8_BAR;
        PG8_STAGEB(PG8_SB(1, 0), cB + kstepB); PG8_STAGEA(PG8_SA(1, 0), cA + kstepA); PG8_STAGEB(PG8_SB(1, 1), cB + hstepB + kstepB);
        PG8_WAIT_V(6); PG8_BAR;
    } else {
        PG8_STAGEB(PG8_SB(0, 0), cB); PG8_STAGEA(PG8_SA(0, 0), cA); PG8_STAGEB(PG8_SB(0, 1), cB + hstepB); PG8_STAGEA(PG8_SA(0, 1), cA + hstepA);
        if (wr == 1) PG8_BAR;
        PG8_WAIT_V(4); PG8_BAR;
        PG8_STAGEB(PG8_SB(1, 0), cB + kstepB); PG8_STAGEA(PG8_SA(1, 0), cA + kstepA); PG8_STAGEB(PG8_SB(1, 1), cB + hstepB + kstepB);
        PG8_WAIT_V(6); PG8_BAR;
    }
    for (;;) {
        const bool has_next = S.next(ui + 1, nxt);
        const char* nA = has_next ? S.abase(nxt) : cA; const char* nB = has_next ? S.bbase(nxt) : cB;
        asm volatile(".p2align 8" ::: "memory");
        for (int t = 0; t < nt; t += 2) {
            if constexpr (Epi::MID) { if (t == (nt >> 1)) E.mid(acc, cur, wr, wc, fr, fq); }
            const bool last = (t == nt - 2);
            const char* a1 = cA + (size_t)(t + 1) * kstepA;
            const char* a2 = last ? nA : cA + (size_t)(t + 2) * kstepA; const char* b2 = last ? nB : cB + (size_t)(t + 2) * kstepB;
            const char* a3 = a2 + kstepA; const char* b3 = b2 + kstepB;
            if constexpr (SP2) {
            PG8_LDB(B0, 0, 0); PG8_LDB(B1, 0, 1); PG8_SCHED; PG8_LDA(At, 0, 0); PG8_STAGEA(PG8_SA(1, 1), a1 + hstepA);
            PG8_WAIT_V(8); PG8_WAIT_L(0); PG8_BAR; PG8_MMA(0, 0, At, B0); PG8_MMA(0, 1, At, B1); PG8_BAR; PG8_SCHED;
            PG8_LDA(At, 0, 1); PG8_STAGEB(PG8_SB(0, 0), b2); PG8_STAGEB(PG8_SB(0, 1), b2 + hstepB); PG8_STAGEA(PG8_SA(0, 0), a2);
            PG8_WAIT_V(8); PG8_WAIT_L(0); PG8_BAR; PG8_MMA(1, 0, At, B0); PG8_MMA(1, 1, At, B1); PG8_BAR; PG8_SCHED;
            PG8_LDB(B0, 1, 0); PG8_LDB(B1, 1, 1); PG8_SCHED; PG8_LDA(At, 1, 0); PG8_STAGEA(PG8_SA(0, 1), a2 + hstepA);
            PG8_WAIT_V(8); PG8_WAIT_L(0); PG8_BAR; PG8_MMA(0, 0, At, B0); PG8_MMA(0, 1, At, B1); PG8_BAR; PG8_SCHED;
            PG8_LDA(At, 1, 1); PG8_STAGEB(PG8_SB(1, 0), b3); PG8_STAGEB(PG8_SB(1, 1), b3 + hstepB); PG8_STAGEA(PG8_SA(1, 0), a3);
            PG8_WAIT_V(8); PG8_WAIT_L(0); PG8_BAR; PG8_MMA(1, 0, At, B0); PG8_MMA(1, 1, At, B1); PG8_BAR; PG8_SCHED;
            } else {
            PG8_LDB(B0, 0, 0); PG8_SCHED; PG8_LDA(At, 0, 0); PG8_STAGEA(PG8_SA(1, 1), a1 + hstepA);
            PG8_WAIT_L(8); PG8_BAR; PG8_WAIT_L(0); PG8_MMA(0, 0, At, B0); PG8_BAR; PG8_SCHED;
            PG8_LDB(B1, 0, 1); PG8_STAGEB(PG8_SB(0, 0), b2);
            PG8_BAR; PG8_WAIT_L(0); PG8_MMA(0, 1, At, B1); PG8_BAR;
            PG8_LDA(At, 0, 1); PG8_STAGEA(PG8_SA(0, 0), a2);
            PG8_BAR; PG8_WAIT_L(0); PG8_MMA(1, 0, At, B0); PG8_BAR; PG8_SCHED;
            PG8_STAGEB(PG8_SB(0, 1), b2 + hstepB);
            PG8_WAIT_V(6); PG8_BAR; PG8_MMA(1, 1, At, B1); PG8_BAR;
            PG8_LDB(B0, 1, 0); PG8_SCHED; PG8_LDA(At, 1, 0); PG8_STAGEA(PG8_SA(0, 1), a2 + hstepA);
            PG8_WAIT_L(8); PG8_BAR; PG8_WAIT_L(0); PG8_MMA(0, 0, At, B0); PG8_BAR; PG8_SCHED;
            PG8_LDB(B1, 1, 1); PG8_STAGEB(PG8_SB(1, 0), b3);
            PG8_BAR; PG8_WAIT_L(0); PG8_MMA(0, 1, At, B1); PG8_BAR;
            PG8_LDA(At, 1, 1); PG8_STAGEA(PG8_SA(1, 0), a3);
            PG8_BAR; PG8_WAIT_L(0); PG8_MMA(1, 0, At, B0); PG8_BAR; PG8_SCHED;
            PG8_STAGEB(PG8_SB(1, 1), b3 + hstepB);
            PG8_WAIT_V(6); PG8_BAR; PG8_MMA(1, 1, At, B1); PG8_BAR;
            }
        }
        if constexpr (ALIGN_EPI) { if (wr == 0) PG8_BAR; }
        if constexpr (!Epi::AFTER_DRAIN) { E(acc, cur, wr, wc, fr, fq); }
        if (!has_next) break;
#pragma unroll
        for (int a = 0; a < 2; ++a)
#pragma unroll
            for (int b = 0; b < 2; ++b)
#pragma unroll
                for (int m = 0; m < 4; ++m)
#pragma unroll
                    for (int n = 0; n < 2; ++n) acc[a][b][m][n] = (f32x4){0.f, 0.f, 0.f, 0.f};
        cur = nxt; cA = nA; cB = nB; ++ui;
        if constexpr (ALIGN_EPI) { if (wr == 1) PG8_BAR; }
    }
    PG8_WAIT_V(0);
    if constexpr (!ALIGN_EPI) { if (wr == 0) PG8_BAR; }
    PG8_BAR;
    if constexpr (Epi::AFTER_DRAIN) { E.fused(acc, cur, wr, wc, fr, fq, lds, wid, lane); }
#undef PG8_SA
#undef PG8_SB
#undef PG8_STAGEX
#undef PG8_STAGEA
#undef PG8_STAGEB
#undef PG8_LDA
#undef PG8_LDB
#undef PG8_MMA
#undef PG8_WAIT_V
#undef PG8_WAIT_L
#undef PG8_BAR
#undef PG8_SCHED
}
}

#define XB_TMO      128
#define XB_XCNT(j)  (256  + 64 * (j))
#define XB_XSUB(j)  (1280 + 64 * (j))
#define XB_XGEN(j)  (2304 + 64 * (j))
#define XB_TOP      3328
#define XB_TOPGEN   3392
#define XCD_BAR_WORDS 3456
#define XB_SPIN_CAP (1u << 18)
__device__ __forceinline__ unsigned xb_ld(unsigned* p)              { return __hip_atomic_load(p, __ATOMIC_RELAXED, __HIP_MEMORY_SCOPE_AGENT); }
__device__ __forceinline__ unsigned xb_add(unsigned* p, unsigned v) { return __hip_atomic_fetch_add(p, v, __ATOMIC_RELAXED, __HIP_MEMORY_SCOPE_AGENT); }
__device__ __forceinline__ unsigned xb_xcc_id() { return (unsigned)__builtin_amdgcn_s_getreg((3 << 11) | 20) & 0xFu; }
#define XB_SPIN(cond, bar) do { unsigned _sp = 0; while (cond) { __builtin_amdgcn_s_sleep(1); \
    if ((++_sp & 255u) == 0u) { if (xb_ld(&(bar)[XB_TMO])) break; if (_sp > XB_SPIN_CAP) { atomicAdd(&(bar)[XB_TMO], 1u); break; } } } } while (0)
struct XcdBarrier { unsigned* bar; unsigned x; volatile LAS unsigned* st; };
__device__ __forceinline__ XcdBarrier xcd_barrier_post(unsigned* bar, volatile LAS unsigned* st) {
    XcdBarrier b; b.bar = bar; b.x = xb_xcc_id(); b.st = st;
    if (threadIdx.x == 0) (void)xb_add(&bar[XB_XCNT(b.x)], 1u);
    return b;
}
__device__ __forceinline__ void xcd_barrier_complete(unsigned* bar, unsigned x, unsigned& nloc, unsigned& nx) {
    const unsigned G = gridDim.x * gridDim.y * gridDim.z;
    unsigned sum, cnt, mine, sp = 0u;
    for (;;) {
        sum = 0u; cnt = 0u; mine = 0u;
#pragma unroll
        for (unsigned j = 0; j < 16; ++j) { const unsigned c = xb_ld(&bar[XB_XCNT(j)]); sum += c; cnt += (c > 0u) ? 1u : 0u; mine = (j == x) ? c : mine; }
        if (sum == G) break;
        __builtin_amdgcn_s_sleep(1);
        if ((++sp & 255u) == 0u) { if (xb_ld(&bar[XB_TMO])) break; if (sp > XB_SPIN_CAP) { atomicAdd(&bar[XB_TMO], 1u); break; } }
    }
    nloc = mine > 0u ? mine : 1u; nx = cnt > 0u ? cnt : 1u;
}
__device__ __forceinline__ void xcd_barrier(const XcdBarrier& b) {
    asm volatile("s_waitcnt vmcnt(0)" ::: "memory");
    __syncthreads();
    if (threadIdx.x == 0) {
        unsigned* bar = b.bar;
        __builtin_amdgcn_s_waitcnt(0);
        unsigned nloc = b.st[0], nx = b.st[1];
        if (nloc == 0u) { xcd_barrier_complete(bar, b.x, nloc, nx); b.st[0] = nloc; b.st[1] = nx; }
        const unsigned old = xb_add(&bar[XB_XSUB(b.x)], 1u);
        const unsigned gen = old / nloc;
        if (old + 1u == (gen + 1u) * nloc) {
            __builtin_amdgcn_fence(__ATOMIC_RELEASE, "agent");
            asm volatile("s_waitcnt vmcnt(0)" ::: "memory");
            const unsigned og = xb_add(&bar[XB_TOP], 1u);
            const unsigned tg = og / nx;
            if (og + 1u == (tg + 1u) * nx) xb_add(&bar[XB_TOPGEN], 1u);
            else XB_SPIN(xb_ld(&bar[XB_TOPGEN]) == tg, bar);
            __builtin_amdgcn_fence(__ATOMIC_ACQUIRE, "agent");
            xb_add(&bar[XB_XGEN(b.x)], 1u);
            asm volatile("s_waitcnt vmcnt(0)" ::: "memory");
        } else {
            XB_SPIN(xb_ld(&bar[XB_TOPGEN]) == gen, bar);
            __builtin_amdgcn_fence(__ATOMIC_ACQUIRE, "agent");
            asm volatile("s_waitcnt vmcnt(0)" ::: "memory");
        }
    }
    __syncthreads();
}

template <class Work>
__device__ __forceinline__ void xcd_barrier_shadow(const XcdBarrier& b, const Work& work) {
    asm volatile("s_waitcnt vmcnt(0)" ::: "memory");
    __syncthreads();
    if (threadIdx.x >= 64) work();
    else if (threadIdx.x == 0) {
        unsigned* bar = b.bar;
        __builtin_amdgcn_s_waitcnt(0);
        unsigned nloc = b.st[0], nx = b.st[1];
        if (nloc == 0u) { xcd_barrier_complete(bar, b.x, nloc, nx); b.st[0] = nloc; b.st[1] = nx; }
        const unsigned old = xb_add(&bar[XB_XSUB(b.x)], 1u);
        const unsigned gen = old / nloc;
        if (old + 1u == (gen + 1u) * nloc) {
            __builtin_amdgcn_fence(__ATOMIC_RELEASE, "agent");
            asm volatile("s_waitcnt vmcnt(0)" ::: "memory");
            const unsigned og = xb_add(&bar[XB_TOP], 1u);
            const unsigned tg = og / nx;
            if (og + 1u == (tg + 1u) * nx) xb_add(&bar[XB_TOPGEN], 1u);
            else XB_SPIN(xb_ld(&bar[XB_TOPGEN]) == tg, bar);
            __builtin_amdgcn_fence(__ATOMIC_ACQUIRE, "agent");
            xb_add(&bar[XB_XGEN(b.x)], 1u);
            asm volatile("s_waitcnt vmcnt(0)" ::: "memory");
        } else {
            XB_SPIN(xb_ld(&bar[XB_TOPGEN]) == gen, bar);
            __builtin_amdgcn_fence(__ATOMIC_ACQUIRE, "agent");
            asm volatile("s_waitcnt vmcnt(0)" ::: "memory");
        }
    }
    __syncthreads();
}

struct GroupBarrier { unsigned* cnt; unsigned gen; bool same_xcd; };
__device__ __forceinline__ void group_barrier(GroupBarrier& gb, unsigned* tmo, unsigned* arrive = nullptr, unsigned* x1 = nullptr, unsigned w1 = 0u, unsigned* x2 = nullptr, unsigned w2 = 0u) {
    asm volatile("s_waitcnt vmcnt(0)" ::: "memory");
    __syncthreads();
    if (threadIdx.x == 0) {
        __builtin_amdgcn_s_waitcnt(0);
        if (gb.gen == 0u) {
            const unsigned long long census = __hip_atomic_load((unsigned long long*)(gb.cnt + 2), __ATOMIC_RELAXED, __HIP_MEMORY_SCOPE_AGENT);
            gb.same_xcd = census == (4ull << (4u * xb_xcc_id())); }
        if (!gb.same_xcd) { __builtin_amdgcn_fence(__ATOMIC_RELEASE, "agent"); asm volatile("s_waitcnt vmcnt(0)" ::: "memory"); }
        if (arrive) (void)xb_add(arrive, 1u);
        (void)xb_add(gb.cnt, 1u);
        const unsigned want = 4u * (gb.gen + 1u);
        { unsigned sp_ = 0u;
          for (;;) { const unsigned c0 = xb_ld(gb.cnt), c1 = x1 ? xb_ld(x1) : w1, c2 = x2 ? xb_ld(x2) : w2;
              if (c0 >= want && c1 >= w1 && c2 >= w2) break;
              __builtin_amdgcn_s_sleep(1);
              if ((++sp_ & 255u) == 0u) { if (xb_ld(&tmo[XB_TMO])) break; if (sp_ > XB_SPIN_CAP) { atomicAdd(&tmo[XB_TMO], 1u); break; } } } }
        __builtin_amdgcn_fence(__ATOMIC_ACQUIRE, "agent");
        asm volatile("s_waitcnt vmcnt(0)" ::: "memory");
    }
    gb.gen += 1u;
    __syncthreads();
}

constexpr int NWAVES = 8;
constexpr int RING_BYTES = 131072, LDSCTL_OFF = RING_BYTES, MISC_OFF = LDSCTL_OFF + 320, LDS_BYTES = 163840;
constexpr int CW_PROG = 16384 + 1024;
constexpr int CW_GRP = 20480;
constexpr int CW_BAR = 4096, CW_CTXROWS = 16384, CW_GEMV = 16384 + 256;

struct Ptrs {
    const float *x, *c, *ctx, *cctx, *ada_w, *ada_b, *n1g, *n2g, *w_in, *pool_w, *pool_scale, *qg, *kg, *rpb, *wbp, *wbn, *w_out, *w1, *w2;
    float* out; unsigned char* ws;
    float *modp, *mod, *bias2, *rowp; f32x2* tab;
    bf16_t *wtin, *wtbr, *wtout, *wt1, *wt2, *kc, *vct, *xn, *u, *qr, *qp, *kr, *vt, *sgp, *sgn, *dn, *mg, *xg, *xnb, *h; float *tmp, *zc;
};
struct Args { const float* in[19]; float* out; unsigned char* ws; int ph_lo, ph_hi, li, pad; };
__device__ __forceinline__ Ptrs make_ptrs(const Args& a) {
    Ptrs P;
    P.x = a.in[0]; P.c = a.in[1]; P.ctx = a.in[2]; P.cctx = a.in[3]; P.ada_w = a.in[4]; P.ada_b = a.in[5]; P.n1g = a.in[6]; P.n2g = a.in[7]; P.w_in = a.in[8]; P.pool_w = a.in[9];
    P.pool_scale = a.in[10]; P.qg = a.in[11]; P.kg = a.in[12]; P.rpb = a.in[13]; P.wbp = a.in[14]; P.wbn = a.in[15]; P.w_out = a.in[16]; P.w1 = a.in[17]; P.w2 = a.in[18];
    P.out = a.out; P.ws = a.ws; unsigned char* ws = a.ws;
    P.modp = (float*)(ws + WS_SMALL + OFF_MODP); P.mod = (float*)(ws + WS_SMALL + OFF_MOD); P.tab = (f32x2*)(ws + WS_SMALL + OFF_TAB);
    P.bias2 = (float*)(ws + WS_SMALL + OFF_BIAS2); P.rowp = (float*)(ws + WS_ROWP);
    P.wtin = (bf16_t*)(ws + WS_WTIN); P.wtbr = (bf16_t*)(ws + WS_WTBR); P.wtout = (bf16_t*)(ws + WS_WTOUT); P.wt1 = (bf16_t*)(ws + WS_WT1); P.wt2 = (bf16_t*)(ws + WS_WT2);
    P.kc = (bf16_t*)(ws + WS_KC); P.vct = (bf16_t*)(ws + WS_VCT); P.xn = (bf16_t*)(ws + WS_XN);
    P.u = (bf16_t*)(ws + WS_U); P.qr = (bf16_t*)(ws + WS_QR); P.qp = (bf16_t*)(ws + WS_QP); P.kr = (bf16_t*)(ws + WS_KR); P.vt = (bf16_t*)(ws + WS_VT);
    P.sgp = (bf16_t*)(ws + WS_SGP); P.sgn = (bf16_t*)(ws + WS_SGN); P.dn = (bf16_t*)(ws + WS_DN); P.mg = (bf16_t*)(ws + WS_MG); P.xnb = (bf16_t*)(ws + WS_XG); P.xg = (bf16_t*)a.out; P.h = (bf16_t*)(ws + WS_H);
    P.tmp = (float*)(ws + WS_TMP); P.zc = (float*)(ws + WS_ZC);
    return P;
}
struct Frame { LAS unsigned char* lds; int tid, lane, wave, vcu, G; };

template <class WMap>
__device__ __forceinline__ void wave_gemm_acc(const bf16_t* A, int lda, const bf16_t* Bt, int ldb, int K, int row0, const WMap& wmap, f32x16& d0, f32x16& d1, int lane) {
    const int r = lane & 31, hi = lane >> 5;
    const bf16_t* ap = A + (size_t)(row0 + r) * lda + 8 * hi;
    const bf16_t* bp0 = Bt + (size_t)wmap(r) * ldb + 8 * hi;
    const bf16_t* bp1 = Bt + (size_t)wmap(32 + r) * ldb + 8 * hi;
    bf16x8 a[4], b0[4], b1[4], an[4], b0n[4], b1n[4];
#define WG_LOAD(A_, B0_, B1_, k_) do { _Pragma("unroll") for (int i = 0; i < 4; ++i) { A_[i] = *(const bf16x8*)(ap + (k_) + 16 * i); B0_[i] = *(const bf16x8*)(bp0 + (k_) + 16 * i); B1_[i] = *(const bf16x8*)(bp1 + (k_) + 16 * i); } } while (0)
#define WG_MMA(A_, B0_, B1_) do { _Pragma("unroll") for (int i = 0; i < 4; ++i) { d0 = __builtin_amdgcn_mfma_f32_32x32x16_bf16(B0_[i], A_[i], d0, 0, 0, 0); d1 = __builtin_amdgcn_mfma_f32_32x32x16_bf16(B1_[i], A_[i], d1, 0, 0, 0); } } while (0)
    WG_LOAD(a, b0, b1, 0);
    for (int k = 0; k < K; k += 128) {
        WG_LOAD(an, b0n, b1n, k + 64);
        WG_MMA(a, b0, b1);
        if (k + 128 < K) WG_LOAD(a, b0, b1, k + 128);
        WG_MMA(an, b0n, b1n);
    }
#undef WG_LOAD
#undef WG_MMA
}
__device__ __forceinline__ int dcol(int blk, int reg, int hi) { return 32 * blk + (reg & 3) + 8 * (reg >> 2) + 4 * hi; }

__device__ __forceinline__ void head_norm_rope(const f32x16& d0, const f32x16& d1, const float* g, const f32x2* tab, int t, int hi, f32x16& y0, f32x16& y1, f32x16& r0, f32x16& r1) {
    float ss = 0.f;
#pragma unroll
    for (int i = 0; i < 16; ++i) ss += d0[i] * d0[i] + d1[i] * d1[i];
    ss += __shfl_xor(ss, 32);
    const float rstd = rsqrtf(ss * (1.0f / 64.0f) + EPS);
#pragma unroll
    for (int i = 0; i < 16; ++i) { y0[i] = d0[i] * rstd * g[dcol(0, i, hi)]; y1[i] = d1[i] * rstd * g[dcol(1, i, hi)]; }
    const int prow = t >> 6, pcol = t & 63;
#pragma unroll
    for (int i = 0; i < 8; ++i) {
        const int di = (i & 3) + 8 * (i >> 2) + 4 * hi;
        const f32x2 cr = tab[prow * 16 + di], cc = tab[pcol * 16 + di];
        r0[i] = y0[i] * cr.x - y0[i + 8] * cr.y; r0[i + 8] = y0[i] * cr.y + y0[i + 8] * cr.x;
        r1[i] = y1[i] * cc.x - y1[i + 8] * cc.y; r1[i + 8] = y1[i] * cc.y + y1[i + 8] * cc.x;
    }
}

template <class RM>
__device__ __forceinline__ void tr_item(const float* W, int ldw, int k0, int n0, bf16_t* Dst, int ldd, int koff, const RM& rm, LAS float* scr, int lane) {
    const int kr = lane >> 3, c4 = lane & 7;
    f32x4 v[8];
#pragma unroll
    for (int i = 0; i < 8; ++i) v[i] = __builtin_nontemporal_load((const f32x4*)(W + (size_t)(k0 + 8 * i + kr) * ldw + n0 + 4 * c4));
#pragma unroll
    for (int i = 0; i < 8; ++i) { LAS float* d = scr + (8 * i + kr) * 33 + 4 * c4; d[0] = v[i][0]; d[1] = v[i][1]; d[2] = v[i][2]; d[3] = v[i][3]; }
    LDS_WAIT(); asm volatile("" ::: "memory");
    const int c = lane & 7;
#pragma unroll
    for (int j = 0; j < 4; ++j) { const int n = (lane >> 3) + 8 * j; const LAS float* s = scr + (8 * c) * 33 + n;
        u32x4 o; o.x = pk2(s[0 * 33], s[1 * 33]); o.y = pk2(s[2 * 33], s[3 * 33]); o.z = pk2(s[4 * 33], s[5 * 33]); o.w = pk2(s[6 * 33], s[7 * 33]);
        *(u32x4*)(Dst + (size_t)rm(n0 + n) * ldd + koff + k0 + 8 * c) = o; }
    LDS_WAIT(); asm volatile("" ::: "memory");
}
struct RmIn { __device__ __forceinline__ int operator()(int n) const { return wrow_in(n); } };
struct RmStd { __device__ __forceinline__ int operator()(int n) const { return wrow_std(n); } };

__device__ __forceinline__ void late_tiles(const Frame& F, const Ptrs& P, int first, int count, int W) {
    const int w = F.wave - 1; if (w < 0 || w >= W) return;
    LAS float* scr = (LAS float*)(F.lds + w * 8704);
    for (int i = F.vcu * W + w; i < count; i += F.G * W) {
        int t = first + i; const float* src; bf16_t* dst; int ldw, ldd, nb;
        if (t < 256) { src = P.wbn; dst = P.wtbr + 512; ldw = DM; ldd = DM; nb = 32; }
        else if ((t -= 256) < 2048) { src = P.w1; dst = P.wt1; ldw = FF; ldd = DM; nb = 128; }
        else if ((t -= 2048) < 512) { src = P.w_out; dst = P.wtout; ldw = DM; ldd = DM; nb = 32; }
        else { t -= 512; src = P.w2; dst = P.wt2; ldw = DM; ldd = FF; nb = 32; }
        tr_item(src, ldw, 64 * (t / nb), 32 * (t % nb), dst, ldd, 0, RmStd(), scr, F.lane);
    }
}

__device__ __forceinline__ void phase0(const Frame& F, const Ptrs& P, int variant = 0) {
    for (int bit = F.vcu; bit < 193 && variant != 8; bit += F.G) {
      if (bit < 192) {
        const int cb = bit % 48, kq = bit / 48;
        LAS float* sl = (LAS float*)F.lds;
        const int col = cb * 128 + (F.tid & 127), kg = F.tid >> 7;
        float a0 = 0.f, a1 = 0.f, a2 = 0.f;
        const float* wp = P.ada_w + (size_t)(kq * 256 + kg * 64) * 6144 + col;
        const int kc_ = kq * 256 + (F.tid & 255);
        const float c01 = P.c[(F.tid >> 8) * DM + kc_], c2 = P.cctx[kc_];
        float wv[64];
#pragma unroll
        for (int k = 0; k < 64; ++k) wv[k] = __builtin_nontemporal_load(wp + (size_t)k * 6144);
        sl[F.tid] = siluf_(c01); if (F.tid < 256) sl[512 + F.tid] = siluf_(c2);
        __syncthreads();
#pragma unroll
        for (int k = 0; k < 64; ++k) { const float w = wv[k]; const int kk = kg * 64 + k; a0 += sl[kk] * w; a1 += sl[256 + kk] * w; a2 += sl[512 + kk] * w; }
        LAS float* pr = (LAS float*)F.lds + 1024;
        pr[(kg * 3 + 0) * 128 + (F.tid & 127)] = a0; pr[(kg * 3 + 1) * 128 + (F.tid & 127)] = a1; pr[(kg * 3 + 2) * 128 + (F.tid & 127)] = a2;
        __syncthreads();
        if (F.tid < 384) { const int v = F.tid >> 7, cl = F.tid & 127; const float s = (pr[(0 * 3 + v) * 128 + cl] + pr[(1 * 3 + v) * 128 + cl]) + (pr[(2 * 3 + v) * 128 + cl] + pr[(3 * 3 + v) * 128 + cl]);
            __hip_atomic_store(P.modp + (size_t)(kq * 3 + v) * 6144 + cb * 128 + cl, s, __ATOMIC_RELAXED, __HIP_MEMORY_SCOPE_AGENT); }
        asm volatile("s_waitcnt vmcnt(0)" ::: "memory");
        __syncthreads();
        if (F.tid == 0) __hip_atomic_fetch_add((unsigned*)(P.ws + WS_CTL) + CW_GEMV, 1u, __ATOMIC_RELAXED, __HIP_MEMORY_SCOPE_AGENT);
      } else {
        for (int i = F.tid; i < 128 * 16; i += 512) { const int pos = i >> 4, fi = i & 15; const float inv = powf(10000.0f, -(float)fi / 16.0f); const float ang = (float)pos * inv; float sn, cs; sincosf(ang, &sn, &cs); P.tab[i] = (f32x2){cs, sn}; }
      }
    }
    if (variant != 7) {
        LAS float* ts = (LAS float*)(F.lds + 16384);
        const bool full = F.G > 224;
        struct TrDesc { const float* src; bf16_t* dst; int ldw, ldd, k0, n0, isin; };
        auto item_of = [&](int rep) {
            int it;
            if (full) {
                if (F.vcu < 32) { if (rep >= 4) return 1 << 30; it = -(1 + 4 * (F.vcu >> 3) + rep); }
                else if (F.vcu < 192) { if (rep >= 3) return 1 << 30; it = rep * 160 + (F.vcu - 32); }
                else { it = 480 + (F.vcu - 192) + rep * (F.G - 192); }
            } else { it = F.vcu + rep * F.G - 64; if (it < 0) it = -(1 + (it + 64)); }
            return it >= 800 ? (1 << 30) : it; };
        auto desc_of = [&](int it) { TrDesc d; int r = it;
            if (r < 0) { const int sp = -1 - r, kb = sp & 15, pnx = full ? (F.vcu & 3) : (sp >> 4); d.src = P.w_in; d.ldw = INW; d.k0 = 64 * kb; d.n0 = 256 * (4 + pnx); d.dst = P.wtin; d.ldd = DM; d.isin = 1; }
            else if (r < 192) { const int nti = r % 12; d.src = P.w_in; d.ldw = INW; d.k0 = 64 * (r / 12); d.n0 = 256 * (nti < 4 ? nti : nti + 4); d.dst = P.wtin; d.ldd = DM; d.isin = 1; }
            else if ((r -= 192) < 32) { d.src = P.wbn; d.ldw = DM; d.k0 = 64 * (r / 4); d.n0 = 256 * (r % 4); d.dst = P.wtbr + 512; d.ldd = DM; d.isin = 0; }
            else if ((r -= 32) < 64) { d.src = P.w_out; d.ldw = DM; d.k0 = 64 * (r / 4); d.n0 = 256 * (r % 4); d.dst = P.wtout; d.ldd = DM; d.isin = 0; }
            else if ((r -= 64) < 256) { d.src = P.w1; d.ldw = FF; d.k0 = 64 * (r / 16); d.n0 = 256 * (r % 16); d.dst = P.wt1; d.ldd = DM; d.isin = 0; }
            else { r -= 256; d.src = P.w2; d.ldw = DM; d.k0 = 64 * (r / 4); d.n0 = 256 * (r % 4); d.dst = P.wt2; d.ldd = FF; d.isin = 0; }
            return d; };
#define TRB_LOAD(v_, d_) do { _Pragma("unroll") for (int j = 0; j < 8; ++j) v_[j] = __builtin_nontemporal_load((const f32x4*)(d_.src + (size_t)(d_.k0 + F.wave + 8 * j) * d_.ldw + d_.n0 + 4 * F.lane)); } while (0)
#define TRB_FINISH(v_, d_) do { \
            _Pragma("unroll") for (int j = 0; j < 8; ++j) { LAS float* q_ = ts + (F.lane >> 3) * 2113 + (F.wave + 8 * j) * 33 + 4 * (F.lane & 7); q_[0] = v_[j][0]; q_[1] = v_[j][1]; q_[2] = v_[j][2]; q_[3] = v_[j][3]; } \
            __syncthreads(); \
            { const int c_ = F.tid & 7; \
              _Pragma("unroll") for (int j = 0; j < 4; ++j) { const int n_ = (F.tid >> 3) + 64 * j; const LAS float* q_ = ts + (n_ >> 5) * 2113 + (8 * c_) * 33 + (n_ & 31); \
                u32x4 o_; o_.x = pk2(q_[0 * 33], q_[1 * 33]); o_.y = pk2(q_[2 * 33], q_[3 * 33]); o_.z = pk2(q_[4 * 33], q_[5 * 33]); o_.w = pk2(q_[6 * 33], q_[7 * 33]); \
                const int row_ = d_.isin ? wrow_in(d_.n0 + n_) : wrow_std(d_.n0 + n_); *(u32x4*)(d_.dst + (size_t)row_ * d_.ldd + d_.k0 + 8 * c_) = o_; } } \
            __syncthreads(); } while (0)
        {
            f32x4 va[8], vb[8]; TrDesc da, db; int rep = 0;
            int ia = item_of(0);
            if (ia != (1 << 30)) { da = desc_of(ia); TRB_LOAD(va, da); }
            while (ia != (1 << 30)) {
                const int ib = item_of(rep + 1);
                if (ib != (1 << 30)) { db = desc_of(ib); TRB_LOAD(vb, db); }
                TRB_FINISH(va, da);
                if (ib == (1 << 30)) break;
                ia = item_of(rep + 2);
                if (ia != (1 << 30)) { da = desc_of(ia); TRB_LOAD(va, da); }
                TRB_FINISH(vb, db);
                rep += 2;
            }
        }
#undef TRB_LOAD
#undef TRB_FINISH
    }
}

__device__ __forceinline__ void fold_items(const Frame& F, const Ptrs& P) {
    if (F.wave < 4) return;
    LAS float* scr = (LAS float*)(F.lds + 16384 + F.wave * 12288);
    for (int r = F.vcu * 4 + F.wave - 4; r < 1024; r += F.G * 4) {
        const int n = (r & 15) * 64 + F.lane, chunk = r >> 4, g = chunk >> 4, c0 = (chunk & 15) * 8;
#pragma unroll
        for (int q = 0; q < 4; ++q) { const int idx = q * 256 + F.lane * 4; *(LAS f32x4*)(scr + idx) = *(const f32x4*)(P.pool_w + (size_t)(g * 128 + c0) * 128 + idx); }
        *(LAS f32x2*)(scr + 1024 + 2 * F.lane) = *(const f32x2*)(P.pool_scale + g * 128 + 2 * F.lane);
        LDS_WAIT(); asm volatile("" ::: "memory");
        float acc[8];
#pragma unroll
        for (int i = 0; i < 8; ++i) acc[i] = 0.f;
        const float* wp = P.wbp + (size_t)(g * 128) * DM + n;
        for (int e0 = 0; e0 < 128; e0 += 64) {
            float wv[64];
#pragma unroll
            for (int e = 0; e < 64; ++e) wv[e] = __builtin_nontemporal_load(wp + (size_t)(e0 + e) * DM);
#pragma unroll
            for (int e = 0; e < 64; ++e) { const float w = wv[e] * scr[1024 + e0 + e];
#pragma unroll
                for (int i = 0; i < 8; ++i) acc[i] += scr[i * 128 + e0 + e] * w; }
        }
        u32x4 o; o.x = pk2(acc[0], acc[1]); o.y = pk2(acc[2], acc[3]); o.z = pk2(acc[4], acc[5]); o.w = pk2(acc[6], acc[7]);
        *(u32x4*)(P.wtbr + (size_t)wrow_std(n) * DM + g * 128 + c0) = o;
        LDS_WAIT(); asm volatile("" ::: "memory");
    }
}

__device__ __forceinline__ float modsum(const float* modp, int v, int col) { return (modp[(size_t)(0 * 3 + v) * 6144 + col] + modp[(size_t)(1 * 3 + v) * 6144 + col]) + (modp[(size_t)(2 * 3 + v) * 6144 + col] + modp[(size_t)(3 * 3 + v) * 6144 + col]); }
__device__ __forceinline__ void phase1(const Frame& F, const Ptrs& P) {
    const bool ctxwg = (F.G > 32) && (F.vcu < 32);
    const int gwl = (F.G > 32 ? F.vcu - 32 : F.vcu) * NWAVES + F.wave, NGWL = ((F.G > 32) ? F.G - 32 : F.G) * NWAVES;
    const int nitv = (SEQ + 5 * NGWL - 1) / (5 * NGWL), NIT = 2 * nitv;
    LAS float* tb = (LAS float*)F.lds;
#define ROWS_LOAD(xv_, it_) do { const int v_ = (it_) / nitv, m0_ = gwl + ((it_) % nitv) * 5 * NGWL; \
        _Pragma("unroll") for (int q = 0; q < 5; ++q) { const int m = min(m0_ + q * NGWL, SEQ - 1); const float* xrow = P.x + ((size_t)v_ * SEQ + m) * DM; \
            _Pragma("unroll") for (int j = 0; j < 4; ++j) xv_[q][j] = __builtin_nontemporal_load((const f32x4*)(xrow + 256 * j + 4 * F.lane)); } } while (0)
#define ROWS_FINISH(xv_, it_) do { const int v_ = (it_) / nitv, m0_ = gwl + ((it_) % nitv) * 5 * NGWL; f32x4 sc[4], sh[4]; \
        _Pragma("unroll") for (int j = 0; j < 4; ++j) { sc[j] = *(const LAS f32x4*)(tb + (v_ * 2 + 0) * 1024 + 256 * j + 4 * F.lane); sh[j] = *(const LAS f32x4*)(tb + (v_ * 2 + 1) * 1024 + 256 * j + 4 * F.lane); } \
        _Pragma("unroll") for (int q = 0; q < 5; ++q) { const int m = m0_ + q * NGWL; if (m < SEQ) { \
            bf16_t* orow = P.xn + ((size_t)v_ * SEQ + m) * DM; float sq = 0.f; \
            _Pragma("unroll") for (int j = 0; j < 4; ++j) sq += (xv_[q][j].x * xv_[q][j].x + xv_[q][j].y * xv_[q][j].y) + (xv_[q][j].z * xv_[q][j].z + xv_[q][j].w * xv_[q][j].w); \
            const float rstd = rsqrtf(wave_sum(sq) * (1.0f / DM) + EPS); \
            _Pragma("unroll") for (int j = 0; j < 4; ++j) { const f32x4 o = xv_[q][j] * rstd * sc[j] + sh[j]; u32x2 w; w.x = pk2(o.x, o.y); w.y = pk2(o.z, o.w); *(u32x2*)(orow + 256 * j + 4 * F.lane) = w; } } } } while (0)
    f32x4 xa[5][4], xb[5][4], xc[4];
    if (!ctxwg) ROWS_LOAD(xa, 0);
    const int mc = F.vcu + F.G * F.wave;
    if (mc < MCTX) {
#pragma unroll
        for (int j = 0; j < 4; ++j) xc[j] = __builtin_nontemporal_load((const f32x4*)(P.ctx + (size_t)mc * DM + 256 * j + 4 * F.lane)); }
    if (F.tid == 0) { unsigned* c = (unsigned*)(P.ws + WS_CTL) + CW_GEMV; unsigned sp = 0;
        while (__hip_atomic_load(c, __ATOMIC_RELAXED, __HIP_MEMORY_SCOPE_AGENT) < 192u) { __builtin_amdgcn_s_sleep(2); if (++sp > (1u << 20)) break; }
        __builtin_amdgcn_fence(__ATOMIC_ACQUIRE, "agent"); asm volatile("s_waitcnt vmcnt(0)" ::: "memory"); }
    __syncthreads();
    for (int i = F.vcu * 512 + F.tid; i < 3 * 6144; i += F.G * 512) { const int v = i / 6144, col = i % 6144; P.mod[i] = modsum(P.modp, v, col) + P.ada_b[col]; }
#pragma unroll
    for (int i0 = 0; i0 < 3 * 1024; i0 += 512) { const int i = i0 + F.tid, v = i >> 10, col = i & 1023;
        tb[(v * 2 + 0) * 1024 + col] = P.n1g[col] * (1.0f + modsum(P.modp, v, 1024 + col) + P.ada_b[1024 + col]); tb[(v * 2 + 1) * 1024 + col] = modsum(P.modp, v, col) + P.ada_b[col]; }
    __syncthreads();
    unsigned* cnt = (unsigned*)(P.ws + WS_CTL) + CW_CTXROWS;
    {
        f32x4 sc[4], sh[4];
#pragma unroll
        for (int j = 0; j < 4; ++j) { sc[j] = *(const LAS f32x4*)(tb + 4 * 1024 + 256 * j + 4 * F.lane); sh[j] = *(const LAS f32x4*)(tb + 5 * 1024 + 256 * j + 4 * F.lane); }
        for (int m = mc; m < MCTX; m += F.G * NWAVES) {
            bf16_t* orow = P.xn + ((size_t)MTOK + m) * DM;
            if (m != mc) {
#pragma unroll
                for (int j = 0; j < 4; ++j) xc[j] = __builtin_nontemporal_load((const f32x4*)(P.ctx + (size_t)m * DM + 256 * j + 4 * F.lane)); }
            float sq = 0.f;
#pragma unroll
            for (int j = 0; j < 4; ++j) sq += (xc[j].x * xc[j].x + xc[j].y * xc[j].y) + (xc[j].z * xc[j].z + xc[j].w * xc[j].w);
            const float rstd = rsqrtf(wave_sum(sq) * (1.0f / DM) + EPS);
#pragma unroll
            for (int j = 0; j < 4; ++j) { const f32x4 o = xc[j] * rstd * sc[j] + sh[j];
                __hip_atomic_store((unsigned long long*)(orow + 256 * j + 4 * F.lane), (unsigned long long)pk2(o.x, o.y) | ((unsigned long long)pk2(o.z, o.w) << 32), __ATOMIC_RELAXED, __HIP_MEMORY_SCOPE_AGENT); }
            asm volatile("s_waitcnt vmcnt(0)" ::: "memory");
            if (F.lane == 0) __hip_atomic_fetch_add(cnt + 64 * (m >> 8), 1u, __ATOMIC_RELAXED, __HIP_MEMORY_SCOPE_AGENT);
        }
    }
    if (!ctxwg) {
        for (int it = 0;;) {
            if (it + 1 < NIT) ROWS_LOAD(xb, it + 1);
            ROWS_FINISH(xa, it);
            if (it + 1 >= NIT) break;
            if (it + 2 < NIT) ROWS_LOAD(xa, it + 2);
            ROWS_FINISH(xb, it + 1);
            it += 2; if (it >= NIT) break;
        }
    }
#undef ROWS_LOAD
#undef ROWS_FINISH
    if (ctxwg) {
        if (F.tid == 0) { unsigned* c = cnt + 64 * ((F.vcu >> 2) & 1); unsigned sp = 0;
            while (__hip_atomic_load(c, __ATOMIC_RELAXED, __HIP_MEMORY_SCOPE_AGENT) < 256u) { __builtin_amdgcn_s_sleep(2); if (++sp > (1u << 20)) break; }
            __builtin_amdgcn_fence(__ATOMIC_ACQUIRE, "agent"); asm volatile("s_waitcnt vmcnt(0)" ::: "memory"); }
    }
    VM_WAIT();
    __syncthreads();
}
__device__ __forceinline__ void bias2_items(const Frame& F, const Ptrs& P, int gw, int NGW) {
    float h0[16], h1[16];
#pragma unroll
    for (int q = 0; q < 4; ++q) { const f32x4 a = *(const f32x4*)(P.mod + 3072 + 16 * F.lane + 4 * q), b = *(const f32x4*)(P.mod + 6144 + 3072 + 16 * F.lane + 4 * q);
#pragma unroll
        for (int e = 0; e < 4; ++e) { h0[4 * q + e] = a[e]; h1[4 * q + e] = b[e]; } }
    for (int p0 = gw; p0 < FF; p0 += 2 * NGW) {
      u32x4 wq[2][2];
#pragma unroll
      for (int j = 0; j < 2; ++j) { const int p = min(p0 + j * NGW, FF - 1); const bf16_t* wr = P.wt1 + (size_t)p * DM + 16 * F.lane; wq[j][0] = *(const u32x4*)wr; wq[j][1] = *(const u32x4*)(wr + 8); }
#pragma unroll
      for (int j = 0; j < 2; ++j) { const int p = p0 + j * NGW; if (p >= FF) break;
        const u32x4 w0 = wq[j][0], w1 = wq[j][1];
        float wf[16]; wf[0] = bflo(w0.x); wf[1] = bfhi(w0.x); wf[2] = bflo(w0.y); wf[3] = bfhi(w0.y); wf[4] = bflo(w0.z); wf[5] = bfhi(w0.z); wf[6] = bflo(w0.w); wf[7] = bfhi(w0.w);
        wf[8] = bflo(w1.x); wf[9] = bfhi(w1.x); wf[10] = bflo(w1.y); wf[11] = bfhi(w1.y); wf[12] = bflo(w1.z); wf[13] = bfhi(w1.z); wf[14] = bflo(w1.w); wf[15] = bfhi(w1.w);
        float s0 = 0.f, s1 = 0.f;
#pragma unroll
        for (int e = 0; e < 16; ++e) { s0 += h0[e] * wf[e]; s1 += h1[e] * wf[e]; }
        s0 = wave_sum(s0); s1 = wave_sum(s1);
        if (F.lane == 0) { const int col = (p & ~255) | fwd_std(p & 255); P.bias2[col] = s0; P.bias2[FF + col] = s1; }
      }
    }
}

__host__ __device__ __forceinline__ size_t kr_index(int b, int t, int h, int d) { const int r = t >> 6, col = t & 63, quad = col >> 2, eq = quad >> 1, par = quad & 1;
    return (size_t)((b * NROWS + r) * NH + h) * 4096 + ((((d >> 5) * 4 + ((d >> 3) & 3)) * 2 + par) * 2 + (eq >> 2)) * 128 + ((col & 3) * 4 + (eq & 3)) * 8 + (d & 7); }
__host__ __device__ __forceinline__ size_t vt_index(int b, int h, int d, int t) { const int r = t >> 6, col = t & 63;
    return (((size_t)((b * NROWS + r) * NH + h) * 8 + (col >> 3)) * 64 + d) * 8 + (col & 7); }

__host__ __device__ __forceinline__ size_t kc_index(int b, int n, int h, int d) { const int g = n >> 5, nn = n & 31, hb = (nn >> 2) & 1, m = 4 * (nn >> 3) + (nn & 3), s = d >> 5, fq = (d >> 3) & 3, j = d & 7;
    return (size_t)((((b * NH + h) * 8 + g) * 2 + hb) * 2 + s) * 512 + (m + 16 * fq) * 8 + j; }
__host__ __device__ __forceinline__ size_t vct_index(int b, int h, int d, int n) { const int g = n >> 5, fq = (n >> 3) & 3, j = n & 7, db = d >> 4, qi = d & 15;
    return (size_t)(((b * NH + h) * 8 + g) * 4 + db) * 512 + (qi + 16 * fq) * 8 + j; }

struct WmIn { int c0; __device__ __forceinline__ int operator()(int i) const { return wrow_in(c0 + i); } };
__device__ __forceinline__ void ctx_kv(const Frame& F, const Ptrs& P) {
    const int gw = F.vcu * NWAVES + F.wave, NGW = F.G * NWAVES;
    for (int it = gw; it < 256; it += NGW) {
        const int rt = it & 15, ht = it >> 4, row0 = rt * 32, hi = F.lane >> 5, r = F.lane & 31;
        f32x16 d0 = {}, d1 = {};
        WmIn wm{1024 + 64 * ht};
        wave_gemm_acc(P.xn + (size_t)MTOK * DM, DM, P.wtin, DM, DM, row0, wm, d0, d1, F.lane);
        const int crow = row0 + r;
        if (ht < 8) {
            float ss = 0.f;
#pragma unroll
            for (int i = 0; i < 16; ++i) ss += d0[i] * d0[i] + d1[i] * d1[i];
            ss += __shfl_xor(ss, 32);
            const float rstd = rsqrtf(ss * (1.0f / 64.0f) + EPS);
#pragma unroll
            for (int i = 0; i < 16; ++i) { const int c0 = dcol(0, i, hi), c1 = dcol(1, i, hi); P.kc[kc_index(crow >> 8, crow & 255, ht, c0)] = f2bf(d0[i] * rstd * P.kg[c0]); P.kc[kc_index(crow >> 8, crow & 255, ht, c1)] = f2bf(d1[i] * rstd * P.kg[c1]); }
        } else {
            const int h = ht - 8, b = crow >> 8, n = crow & 255;
#pragma unroll
            for (int i = 0; i < 16; ++i) { const int c0 = dcol(0, i, hi), c1 = dcol(1, i, hi); P.vct[vct_index(b, h, c0, n)] = f2bf(d0[i]); P.vct[vct_index(b, h, c1, n)] = f2bf(d1[i]); }
        }
    }
}

__device__ __forceinline__ void pool_item(const Ptrs& P, int row, int chunk) {
    const int b = row >> 13, t = row & (SEQ - 1), w = 2 << (chunk >> 4);
    const int lo = max(t - (w >> 1), 0), hi = min(t + (w >> 1), SEQ);
    float s[8];
#pragma unroll
    for (int i = 0; i < 8; ++i) s[i] = 0.f;
    for (int tt = lo; tt < hi; ++tt) { const u32x4 v = *(const u32x4*)(P.u + ((size_t)b * SEQ + tt) * PW + chunk * 8);
        s[0] += bflo(v.x); s[1] += bfhi(v.x); s[2] += bflo(v.y); s[3] += bfhi(v.y); s[4] += bflo(v.z); s[5] += bfhi(v.z); s[6] += bflo(v.w); s[7] += bfhi(v.w); }
    const u32x4 c = *(const u32x4*)(P.u + (size_t)row * PW + chunk * 8);
    const float inv = 1.0f / (float)(hi - lo);
    u32x4 o; o.x = pk2(s[0] * inv - bflo(c.x), s[1] * inv - bfhi(c.x)); o.y = pk2(s[2] * inv - bflo(c.y), s[3] * inv - bfhi(c.y));
    o.z = pk2(s[4] * inv - bflo(c.z), s[5] * inv - bfhi(c.z)); o.w = pk2(s[6] * inv - bflo(c.w), s[7] * inv - bfhi(c.w));
    *(u32x4*)(P.dn + (size_t)row * DM + chunk * 8) = o;
}
template <int W> __device__ __forceinline__ void pool_item_w(const Ptrs& P, int row, int chunk) {
    const int b = row >> 13, t = row & (SEQ - 1);
    const int lo = max(t - W / 2, 0), hi = min(t + W / 2, SEQ);
    u32x4 v[W];
#pragma unroll
    for (int i = 0; i < W; ++i) { const int tt = min(max(t - W / 2 + i, 0), SEQ - 1); v[i] = *(const u32x4*)(P.u + ((size_t)b * SEQ + tt) * PW + chunk * 8); }
    float s[8];
#pragma unroll
    for (int i = 0; i < 8; ++i) s[i] = 0.f;
#pragma unroll
    for (int i = 0; i < W; ++i) { const int tt = t - W / 2 + i; const float m = (tt >= 0 && tt < SEQ) ? 1.0f : 0.0f;
        s[0] += m * bflo(v[i].x); s[1] += m * bfhi(v[i].x); s[2] += m * bflo(v[i].y); s[3] += m * bfhi(v[i].y); s[4] += m * bflo(v[i].z); s[5] += m * bfhi(v[i].z); s[6] += m * bflo(v[i].w); s[7] += m * bfhi(v[i].w); }
    const u32x4 c = v[W / 2];
    const float inv = 1.0f / (float)(hi - lo);
    u32x4 o; o.x = pk2(s[0] * inv - bflo(c.x), s[1] * inv - bfhi(c.x)); o.y = pk2(s[2] * inv - bflo(c.y), s[3] * inv - bfhi(c.y));
    o.z = pk2(s[4] * inv - bflo(c.z), s[5] * inv - bfhi(c.z)); o.w = pk2(s[6] * inv - bflo(c.w), s[7] * inv - bfhi(c.w));
    *(u32x4*)(P.dn + (size_t)row * DM + chunk * 8) = o;
}

template <int W> __device__ __forceinline__ void pool_seg8(const Ptrs& P, int b, int t0, int chunk) {
    const bf16_t* ub = P.u + (size_t)b * SEQ * PW + chunk * 8;
    auto ld = [&](int t) { return *(const u32x4*)(ub + (size_t)min(max(t, 0), SEQ - 1) * PW); };
    auto acc = [&](float (&s)[8], const u32x4& v, float m) { s[0] += m * bflo(v.x); s[1] += m * bfhi(v.x); s[2] += m * bflo(v.y); s[3] += m * bfhi(v.y); s[4] += m * bflo(v.z); s[5] += m * bfhi(v.z); s[6] += m * bflo(v.w); s[7] += m * bfhi(v.w); };
    u32x4 w[W];
#pragma unroll
    for (int i = 0; i < W; ++i) w[i] = ld(t0 - W / 2 + i);
    u32x4 vin[7], vout[7], cen[8];
#pragma unroll
    for (int i = 0; i < 7; ++i) { vin[i] = ld(t0 + i + W / 2); vout[i] = ld(t0 + i - W / 2); }
#pragma unroll
    for (int i = 0; i < 8; ++i) cen[i] = (i < W / 2) ? w[W / 2 + i] : vin[i - W / 2];
    float s[8];
#pragma unroll
    for (int e = 0; e < 8; ++e) s[e] = 0.f;
#pragma unroll
    for (int i = 0; i < W; ++i) { const int t = t0 - W / 2 + i; acc(s, w[i], (t >= 0 && t < SEQ) ? 1.0f : 0.0f); }
#pragma unroll
    for (int i = 0; i < 8; ++i) {
        const int t = t0 + i, lo = max(t - W / 2, 0), hi = min(t + W / 2, SEQ);
        const float inv = 1.0f / (float)(hi - lo); const u32x4 c = cen[i];
        u32x4 o; o.x = pk2(s[0] * inv - bflo(c.x), s[1] * inv - bfhi(c.x)); o.y = pk2(s[2] * inv - bflo(c.y), s[3] * inv - bfhi(c.y));
        o.z = pk2(s[4] * inv - bflo(c.z), s[5] * inv - bfhi(c.z)); o.w = pk2(s[6] * inv - bflo(c.w), s[7] * inv - bfhi(c.w));
        *(u32x4*)(P.dn + ((size_t)b * SEQ + t) * DM + chunk * 8) = o;
        if (i < 7) { acc(s, vin[i], (t + W / 2 < SEQ) ? 1.0f : 0.0f); acc(s, vout[i], (t - W / 2 >= 0) ? -1.0f : 0.0f); }
    }
}

struct WmStd { int c0; __device__ __forceinline__ int operator()(int i) const { return wrow_std(c0 + i); } };
__global__ void __launch_bounds__(512) naive_g1(Args a) {
    const Ptrs P = make_ptrs(a); Frame F; F.tid = threadIdx.x; F.lane = F.tid & 63; F.wave = F.tid >> 6; F.vcu = blockIdx.x; F.G = gridDim.x; F.lds = nullptr;
    ctx_kv(F, P);
    const int gw = blockIdx.x * 8 + F.wave, NGW = gridDim.x * 8, lane = F.lane, hi = lane >> 5, r = lane & 31;
    for (int it = gw; it < (MTOK / 32) * (INW / 64); it += NGW) {
        const int ct = it % (INW / 64), rt = it / (INW / 64), row0 = rt * 32, col0 = ct * 64, row = row0 + r;
        f32x16 d0 = {}, d1 = {};
        WmIn wm{col0};
        wave_gemm_acc(P.xn, DM, P.wtin, DM, DM, row0, wm, d0, d1, lane);
        if (col0 < 512) {
#pragma unroll
            for (int i = 0; i < 16; ++i) { P.u[(size_t)row * PW + col0 + dcol(0, i, hi)] = f2bf(d0[i]); P.u[(size_t)row * PW + col0 + dcol(1, i, hi)] = f2bf(d1[i]); }
        } else if (col0 < 1536) {
            const bool isq = col0 < 1024; const int h = ((col0 - 512) & 511) >> 6;
            f32x16 y0, y1, r0, r1;
            head_norm_rope(d0, d1, isq ? P.qg : P.kg, P.tab, row & (SEQ - 1), hi, y0, y1, r0, r1);
#pragma unroll
            for (int i = 0; i < 16; ++i) { const size_t o0 = (size_t)row * NAW + h * 64 + dcol(0, i, hi), o1 = (size_t)row * NAW + h * 64 + dcol(1, i, hi);
                if (isq) { P.qp[o0] = f2bf(0.125f * y0[i]); P.qp[o1] = f2bf(0.125f * y1[i]); P.qr[o0] = f2bf(0.125f * r0[i]); P.qr[o1] = f2bf(0.125f * r1[i]); }
                else { P.kr[kr_index(row >> 13, row & (SEQ - 1), h, dcol(0, i, hi))] = f2bf(r0[i]); P.kr[kr_index(row >> 13, row & (SEQ - 1), h, dcol(1, i, hi))] = f2bf(r1[i]); } }
        } else if (col0 < 2048) {
            const int h = (col0 - 1536) >> 6, b = row >> 13, t = row & (SEQ - 1);
#pragma unroll
            for (int i = 0; i < 16; ++i) { P.vt[vt_index(b, h, dcol(0, i, hi), t)] = f2bf(d0[i]); P.vt[vt_index(b, h, dcol(1, i, hi), t)] = f2bf(d1[i]); }
        } else {
            bf16_t* dst = (col0 < 3072) ? P.sgp : P.sgn; const int cb = (col0 < 3072) ? col0 - 2048 : col0 - 3072;
#pragma unroll
            for (int i = 0; i < 16; ++i) { dst[(size_t)row * DM + cb + dcol(0, i, hi)] = f2bf(sigmoidf_(d0[i])); dst[(size_t)row * DM + cb + dcol(1, i, hi)] = f2bf(sigmoidf_(d1[i])); }
        }
    }
}
__global__ void __launch_bounds__(256) naive_attn(Args a) {
    const Ptrs P = make_ptrs(a);
    for (int i = blockIdx.x * 256 + threadIdx.x; i < MTOK * 64; i += gridDim.x * 256) pool_item(P, i >> 6, i & 63);
    for (int i = blockIdx.x * 256 + threadIdx.x; i < MTOK * NH; i += gridDim.x * 256) {
        const int h = i & 7, row = i >> 3, b = row >> 13, t = row & (SEQ - 1), r = t >> 6, c = t & 63;
        const int r0 = min(max(r - 4, 0), NROWS - 8), c0 = min(max(c - 8, 0), GW - 16);
        float q[64], qp[64], o[64];
#pragma unroll
        for (int d = 0; d < 64; ++d) { q[d] = bf2f(P.qr[(size_t)row * NAW + h * 64 + d]); qp[d] = bf2f(P.qp[(size_t)row * NAW + h * 64 + d]); o[d] = 0.f; }
        float mx = -1e30f, l = 0.f;
        for (int kk = 0; kk < 128 + CTXL; ++kk) {
            float s = 0.f;
            if (kk < 128) { const int kr = r0 + (kk >> 4), kcn = c0 + (kk & 15);
#pragma unroll
                for (int d = 0; d < 64; ++d) s += q[d] * bf2f(P.kr[kr_index(b, kr * 64 + kcn, h, d)]);
                s += P.rpb[(h * 15 + (kr - r + 7)) * 31 + (kcn - c + 15)];
            } else { const int n = kk - 128;
#pragma unroll
                for (int d = 0; d < 64; ++d) s += qp[d] * bf2f(P.kc[kc_index(b, n, h, d)]); }
            const float mn = fmaxf(mx, s), f = __expf(mx - mn), p = __expf(s - mn);
            l = l * f + p;
#pragma unroll
            for (int d = 0; d < 64; ++d) o[d] = o[d] * f + p * bf2f(kk < 128 ? P.vt[vt_index(b, h, d, (r0 + (kk >> 4)) * 64 + c0 + (kk & 15))] : P.vct[vct_index(b, h, d, kk - 128)]);
            mx = mn;
        }
        const float il = 1.0f / l;
#pragma unroll
        for (int d = 0; d < 64; ++d) P.dn[(size_t)row * DM + 512 + h * 64 + d] = f2bf(o[d] * il);
    }
}
__global__ void __launch_bounds__(512) naive_g2(Args a) {
    const Ptrs P = make_ptrs(a); const int lane = threadIdx.x & 63, hi = lane >> 5, r = lane & 31;
    const int gw = blockIdx.x * 8 + (threadIdx.x >> 6), NGW = gridDim.x * 8;
    for (int it = gw; it < (MTOK / 32) * (DM / 64); it += NGW) {
        const int ct = it % (DM / 64), rt = it / (DM / 64), row0 = rt * 32, col0 = ct * 64, row = row0 + r;
        f32x16 d0 = {}, d1 = {}, e0 = {}, e1 = {};
        WmStd wm{col0};
        wave_gemm_acc(P.dn, DM, P.wtbr, DM, 512, row0, wm, d0, d1, lane);
        wave_gemm_acc(P.dn + 512, DM, P.wtbr + 512, DM, 512, row0, wm, e0, e1, lane);
#pragma unroll
        for (int i = 0; i < 16; ++i) { const size_t o0 = (size_t)row * DM + col0 + dcol(0, i, hi), o1 = (size_t)row * DM + col0 + dcol(1, i, hi);
            P.mg[o0] = f2bf(bf2f(P.sgp[o0]) * d0[i] + bf2f(P.sgn[o0]) * e0[i]); P.mg[o1] = f2bf(bf2f(P.sgp[o1]) * d1[i] + bf2f(P.sgn[o1]) * e1[i]); }
    }
}
__global__ void __launch_bounds__(512) naive_g3(Args a) {
    const Ptrs P = make_ptrs(a); const int lane = threadIdx.x & 63, hi = lane >> 5, r = lane & 31;
    const int gw = blockIdx.x * 8 + (threadIdx.x >> 6), NGW = gridDim.x * 8;
    for (int it = gw; it < (MTOK / 32) * 4; it += NGW) {
        const int pn = it & 3, rt = it >> 2, row0 = rt * 32, row = row0 + r, b = row >> 13;
        for (int q = 0; q < 4; ++q) {
            float ss = 0.f;
            const int col0 = pn * 256 + q * 64;
            f32x16 d0 = {}, d1 = {};
            WmStd wm{col0};
            wave_gemm_acc(P.mg, DM, P.wtout, DM, DM, row0, wm, d0, d1, lane);
#pragma unroll
            for (int i = 0; i < 16; ++i)
#pragma unroll
                for (int blk = 0; blk < 2; ++blk) { const int col = col0 + dcol(blk, i, hi); const size_t o = (size_t)row * DM + col;
                    const float xn = P.x[o] + P.mod[b * 6144 + 2048 + col] * (blk ? d1[i] : d0[i]);
                    P.xnb[o] = f2bf(xn); P.xg[o] = f2bf(xn * P.n2g[col] * (1.0f + P.mod[b * 6144 + 4096 + col])); ss += xn * xn; }
            ss += __shfl_xor(ss, 32);
            if (hi == 0) P.rowp[(size_t)row * 16 + pn * 4 + q] = ss;
        }
    }
}
__global__ void __launch_bounds__(512) naive_g4(Args a) {
    const Ptrs P = make_ptrs(a); const int lane = threadIdx.x & 63, hi = lane >> 5, r = lane & 31;
    const int gw = blockIdx.x * 8 + (threadIdx.x >> 6), NGW = gridDim.x * 8;
    for (int it = gw; it < (MTOK / 32) * (FF / 64); it += NGW) {
        const int ct = it % (FF / 64), rt = it / (FF / 64), row0 = rt * 32, col0 = ct * 64, row = row0 + r, b = row >> 13;
        f32x16 d0 = {}, d1 = {};
        WmStd wm{col0};
        wave_gemm_acc(P.xg, DM, P.wt1, DM, DM, row0, wm, d0, d1, lane);
        float sq = 0.f;
#pragma unroll
        for (int q = 0; q < 4; ++q) { const f32x4 rp = *(const f32x4*)(P.rowp + (size_t)row * 16 + 4 * q); sq += (rp.x + rp.y) + (rp.z + rp.w); }
        const float rstd = rsqrtf(sq * (1.0f / DM) + EPS);
#pragma unroll
        for (int i = 0; i < 16; ++i)
#pragma unroll
            for (int blk = 0; blk < 2; ++blk) { const int col = col0 + dcol(blk, i, hi); const float v = fmaxf(rstd * (blk ? d1[i] : d0[i]) + P.bias2[b * FF + col], 0.f); P.h[(size_t)row * FF + col] = f2bf(v * v); }
    }
}
__global__ void __launch_bounds__(512) naive_g5(Args a) {
    const Ptrs P = make_ptrs(a); const int lane = threadIdx.x & 63, hi = lane >> 5, r = lane & 31;
    const int gw = blockIdx.x * 8 + (threadIdx.x >> 6), NGW = gridDim.x * 8;
    for (int it = gw; it < (MTOK / 32) * (DM / 64); it += NGW) {
        const int ct = it % (DM / 64), rt = it / (DM / 64), row0 = rt * 32, col0 = ct * 64, row = row0 + r, b = row >> 13;
        f32x16 d0 = {}, d1 = {};
        WmStd wm{col0};
        wave_gemm_acc(P.h, FF, P.wt2, FF, FF, row0, wm, d0, d1, lane);
#pragma unroll
        for (int i = 0; i < 16; ++i)
#pragma unroll
            for (int blk = 0; blk < 2; ++blk) { const int col = col0 + dcol(blk, i, hi); const size_t o = (size_t)row * DM + col; P.out[o] = bf2f(P.xnb[o]) + P.mod[b * 6144 + 5120 + col] * (blk ? d1[i] : d0[i]); }
    }
}


constexpr size_t TILEB = 256 * 2;
struct SchedG1 {
    const char *xn, *wt; int G, c;
    __device__ __forceinline__ bool next(int i, pg8::Unit& u) const { if (!pg8::static_tile(MTOK / 256, INW / 256, G, c, i, u.pm, u.pn)) return false; u.kind = (u.pn == 6 || u.pn == 7) ? 1 : 0; return true; }
    __device__ __forceinline__ const char* abase(const pg8::Unit& u) const { return u.kind ? wt + (size_t)(256 * u.pn) * (DM * 2) : xn + (size_t)(256 * u.pm) * (DM * 2); }
    __device__ __forceinline__ const char* bbase(const pg8::Unit& u) const { return u.kind ? xn + (size_t)(256 * u.pm) * (DM * 2) : wt + (size_t)(256 * u.pn) * (DM * 2); }
};
struct SchedG2 {
    const char *dn, *wt; int G, c;
    __device__ __forceinline__ bool next(int i, pg8::Unit& u) const { if (!pg8::static_tile(MTOK / 256, DM / 256, G, c, i >> 1, u.pm, u.pn)) return false; u.kind = i & 1; return true; }
    __device__ __forceinline__ const char* abase(const pg8::Unit& u) const { return dn + (size_t)(256 * u.pm) * (DM * 2) + u.kind * 1024; }
    __device__ __forceinline__ const char* bbase(const pg8::Unit& u) const { return wt + (size_t)(256 * u.pn) * (DM * 2) + u.kind * 1024; }
};
struct SchedG4 {
    const char *a, *b; int G, c;
    __device__ __forceinline__ bool next(int i, pg8::Unit& u) const { if (!pg8::static_tile(MTOK / 256, FF / 256, G, c, i, u.pm, u.pn)) return false; u.kind = i; return true; }
    __device__ __forceinline__ const char* abase(const pg8::Unit& u) const { return a + (size_t)u.pm * (256 * DM * 4); }
    __device__ __forceinline__ const char* bbase(const pg8::Unit& u) const { return b + (size_t)(256 * u.pn) * (DM * 2); }
};
struct SchedStd {
    const char *a, *b; int nM, nN, ldb2, G, c;
    __device__ __forceinline__ bool next(int i, pg8::Unit& u) const { if (!pg8::static_tile(nM, nN, G, c, i, u.pm, u.pn)) return false; u.kind = i; return true; }
    __device__ __forceinline__ const char* abase(const pg8::Unit& u) const { return a + (size_t)(256 * u.pm) * ldb2; }
    __device__ __forceinline__ const char* bbase(const pg8::Unit& u) const { return b + (size_t)(256 * u.pn) * ldb2; }
};
typedef f32x4 acc_t[2][2][4][2];
__host__ __device__ __forceinline__ size_t t1k_index(int row, int col) { return ((size_t)((row >> 8) * (DM / 64) + (col >> 6)) * 256 + (row & 255)) * 64 + (col & 63); }
__host__ __device__ __forceinline__ size_t h_index(int row, int col) { return ((size_t)((row >> 8) * (FF / 64) + (col >> 6)) * 256 + (row & 255)) * 64 + (col & 63); }

struct EpiG1 {
    static constexpr bool AFTER_DRAIN = false, MID = false;
    bf16_t *u, *qr, *qp, *kr, *vt, *sgp, *sgn; const float *qg, *kg; const LAS f32x2* tab; int skip;
    __device__ __forceinline__ void operator()(const acc_t& acc, const pg8::Unit& un, int wr, int wc, int fr, int fq) const {
        const int pn = un.pn;
        if (skip == 5) return;
        if (un.kind == 1) {
            const int b = un.pm >> 5, t0 = (un.pm & 31) * 256 + 32 * wc + 4 * fq;
#pragma unroll
            for (int ai = 0; ai < 2; ++ai)
#pragma unroll
                for (int m = 0; m < 4; ++m) { const int ch = 256 * (pn - 6) + 128 * ai + 64 * wr + 16 * m + fr;
#pragma unroll
                    for (int bj = 0; bj < 2; ++bj)
#pragma unroll
                        for (int n = 0; n < 2; ++n) { const f32x4 v = acc[ai][bj][m][n]; u32x2 w; w.x = pk2(v[0], v[1]); w.y = pk2(v[2], v[3]); *(u32x2*)(vt + vt_index(b, ch >> 6, ch & 63, t0 + 128 * bj + 16 * n)) = w; } }
        } else if (pn >= 2 && pn <= 5) {
            const bool isq = pn < 4; const int head = 4 * (pn - (isq ? 2 : 4)) + wc, fh = fq >> 1, fl = fq & 1;
            const float* g = isq ? qg : kg;
            f32x4 gv[2][2];
#pragma unroll
            for (int bj = 0; bj < 2; ++bj)
#pragma unroll
                for (int n = 0; n < 2; ++n) gv[bj][n] = *(const f32x4*)(g + 32 * fh + 16 * bj + 8 * fl + 4 * n);
            const float osc = isq ? 0.125f : 1.0f;
#pragma unroll
            for (int ai = 0; ai < 2; ++ai)
#pragma unroll
                for (int m = 0; m < 4; ++m) {
                    const int row = 256 * un.pm + 128 * ai + 64 * wr + 16 * m + fr, t = row & (SEQ - 1), pos = fh ? (t & 63) : (t >> 6);
                    float ss = 0.f;
#pragma unroll
                    for (int bj = 0; bj < 2; ++bj)
#pragma unroll
                        for (int n = 0; n < 2; ++n) { const f32x4 v = acc[ai][bj][m][n]; ss += (v[0] * v[0] + v[1] * v[1]) + (v[2] * v[2] + v[3] * v[3]); }
                    ss = sum_x16_x32(ss);
                    const float rstd = rsqrtf(ss * (1.0f / 64.0f) + EPS) * osc;
                    f32x4 y[2][2];
#pragma unroll
                    for (int bj = 0; bj < 2; ++bj)
#pragma unroll
                        for (int n = 0; n < 2; ++n) y[bj][n] = acc[ai][bj][m][n] * rstd * gv[bj][n];
                    const size_t off = (size_t)row * NAW + head * 64 + 32 * fh + 8 * fl;
                    if (isq) {
#pragma unroll
                        for (int bj = 0; bj < 2; ++bj) { u32x4 w; w.x = pk2(y[bj][0][0], y[bj][0][1]); w.y = pk2(y[bj][0][2], y[bj][0][3]); w.z = pk2(y[bj][1][0], y[bj][1][1]); w.w = pk2(y[bj][1][2], y[bj][1][3]); *(u32x4*)(qp + off + 16 * bj) = w; }
                    }
                    f32x4 o1[2], o2[2];
#pragma unroll
                    for (int n = 0; n < 2; ++n) { const f32x4 ca = *(const LAS f32x4*)(tab + pos * 16 + 8 * fl + 4 * n), cb = *(const LAS f32x4*)(tab + pos * 16 + 8 * fl + 4 * n + 2);
                        const f32x4 cs = {ca[0], ca[2], cb[0], cb[2]}, sn = {ca[1], ca[3], cb[1], cb[3]};
                        o1[n] = y[0][n] * cs - y[1][n] * sn; o2[n] = y[0][n] * sn + y[1][n] * cs; }
                    bf16_t* d1p = isq ? qr + off : kr + kr_index(row >> 13, t, head, 32 * fh + 8 * fl); bf16_t* d2p = isq ? qr + off + 16 : kr + kr_index(row >> 13, t, head, 32 * fh + 16 + 8 * fl);
                    { u32x4 w; w.x = pk2(o1[0][0], o1[0][1]); w.y = pk2(o1[0][2], o1[0][3]); w.z = pk2(o1[1][0], o1[1][1]); w.w = pk2(o1[1][2], o1[1][3]); *(u32x4*)d1p = w; }
                    { u32x4 w; w.x = pk2(o2[0][0], o2[0][1]); w.y = pk2(o2[0][2], o2[0][3]); w.z = pk2(o2[1][0], o2[1][1]); w.w = pk2(o2[1][2], o2[1][3]); *(u32x4*)d2p = w; }
                }
        } else {
            bf16_t* dst; int ldd, cb; bool sig;
            if (pn < 2) { dst = u; ldd = PW; cb = 256 * pn; sig = false; } else if (pn < 12) { dst = sgp; ldd = DM; cb = 256 * (pn - 8); sig = true; } else { dst = sgn; ldd = DM; cb = 256 * (pn - 12); sig = true; }
#pragma unroll
            for (int ai = 0; ai < 2; ++ai)
#pragma unroll
                for (int m = 0; m < 4; ++m) { const int row = 256 * un.pm + 128 * ai + 64 * wr + 16 * m + fr;
#pragma unroll
                    for (int bj = 0; bj < 2; ++bj) { f32x4 v0 = acc[ai][bj][m][0], v1 = acc[ai][bj][m][1];
                        if (sig) {
#pragma unroll
                            for (int e = 0; e < 4; ++e) { v0[e] = sigmoidf_(v0[e]); v1[e] = sigmoidf_(v1[e]); } }
                        u32x4 w; w.x = pk2(v0[0], v0[1]); w.y = pk2(v0[2], v0[3]); w.z = pk2(v1[0], v1[1]); w.w = pk2(v1[2], v1[3]);
                        *(u32x4*)(dst + (size_t)row * ldd + cb + 128 * bj + 32 * wc + 8 * fq) = w; } }
        }
    }
};

struct SchedCtx {
    const char *xn, *wt; int id;
    __device__ __forceinline__ bool next(int i, pg8::Unit& u) const { if (i != 0) return false; u.pm = (id >> 2) & 1; u.pn = id & 3; u.kind = id >> 3; return true; }
    __device__ __forceinline__ const char* abase(const pg8::Unit& u) const { return xn + (size_t)(MTOK + 256 * u.pm) * (DM * 2) + u.kind * 512; }
    __device__ __forceinline__ const char* bbase(const pg8::Unit& u) const { return wt + (size_t)(1024 + 256 * u.pn) * (DM * 2) + u.kind * 512; }
};
struct EpiCtx {
    static constexpr bool AFTER_DRAIN = false, MID = false;
    float* zc;
    __device__ __forceinline__ void operator()(const acc_t& acc, const pg8::Unit& un, int wr, int wc, int fr, int fq) const {
        float* base = zc + ((size_t)un.kind * MCTX + 256 * un.pm + 64 * wr + fr) * 1024 + 256 * un.pn + 32 * wc + 4 * fq;
#pragma unroll
        for (int ai = 0; ai < 2; ++ai)
#pragma unroll
            for (int m = 0; m < 4; ++m)
#pragma unroll
                for (int bj = 0; bj < 2; ++bj)
#pragma unroll
                    for (int n = 0; n < 2; ++n) *(f32x4*)(base + (size_t)(128 * ai + 16 * m) * 1024 + 128 * bj + 16 * n) = acc[ai][bj][m][n];
    }
};
__device__ __forceinline__ void ctx_finalize(const Frame& F, const Ptrs& P) {
    const int gw = F.vcu * NWAVES + F.wave, NGW = F.G * NWAVES;
    for (int it = gw; it < MCTX * 4; it += NGW) {
        const int row = it >> 2, t = it & 3, b = row >> 8, nt = row & 255;
        f32x4 v = {0.f, 0.f, 0.f, 0.f};
#pragma unroll
        for (int kq = 0; kq < 4; ++kq) v += *(const f32x4*)(P.zc + ((size_t)kq * MCTX + row) * 1024 + 256 * t + 4 * F.lane);
        if (t < 2) {
            const int bj = F.lane >> 5, wc = (F.lane >> 3) & 3, n = (F.lane >> 2) & 1, fq = F.lane & 3, d0 = 32 * (fq >> 1) + 16 * bj + 8 * (fq & 1) + 4 * n;
            float ss = (v[0] * v[0] + v[1] * v[1]) + (v[2] * v[2] + v[3] * v[3]);
            ss += __shfl_xor(ss, 1); ss += __shfl_xor(ss, 2); ss += __shfl_xor(ss, 4); ss += __shfl_xor(ss, 32);
            const float rstd = rsqrtf(ss * (1.0f / 64.0f) + EPS);
            const f32x4 g = *(const f32x4*)(P.kg + d0), y = v * rstd * g;
            u32x2 w; w.x = pk2(y[0], y[1]); w.y = pk2(y[2], y[3]);
            *(u32x2*)(P.kc + kc_index(b, nt, 4 * t + wc, d0)) = w;
        } else {
            const int ch = 256 * (t - 2) + 4 * F.lane;
#pragma unroll
            for (int j = 0; j < 4; ++j) P.vct[vct_index(b, (ch + j) >> 6, (ch + j) & 63, nt)] = f2bf(v[j]);
        }
    }
}

struct EpiG2 {
    static constexpr bool AFTER_DRAIN = false, MID = true;
    const bf16_t *sgp, *sgn; bf16_t* mg;
    __device__ __forceinline__ void mid(acc_t& acc, const pg8::Unit& un, int wr, int wc, int fr, int fq) const {
        unsigned po = (unsigned)((256 * un.pm + 64 * wr + fr) * DM + 256 * un.pn + 32 * wc + 8 * fq);
        u32x4 a[2][2], c[2][2];
#pragma unroll
        for (int bj = 0; bj < 2; ++bj) { a[0][bj] = __builtin_nontemporal_load((const u32x4*)(sgp + po + 128 * bj)); c[0][bj] = *(const u32x4*)(sgn + po + 128 * bj); }
#pragma unroll
        for (int g = 0; g < 8; ++g) { const int ai = g >> 2, m = g & 3, cur = g & 1, nxt = cur ^ 1;
            if (g < 7) { po += (unsigned)((m == 3 ? 80 : 16) * DM); asm volatile("" : "+v"(po));
#pragma unroll
                for (int bj = 0; bj < 2; ++bj) { a[nxt][bj] = __builtin_nontemporal_load((const u32x4*)(sgp + po + 128 * bj)); c[nxt][bj] = *(const u32x4*)(sgn + po + 128 * bj); } }
#pragma unroll
            for (int bj = 0; bj < 2; ++bj) { const u32x4 av = a[cur][bj], cv = c[cur][bj];
                const f32x4 p0 = {bflo(av.x), bfhi(av.x), bflo(av.y), bfhi(av.y)}, p1 = {bflo(av.z), bfhi(av.z), bflo(av.w), bfhi(av.w)};
                const f32x4 n0 = {bflo(cv.x), bfhi(cv.x), bflo(cv.y), bfhi(cv.y)}, n1 = {bflo(cv.z), bfhi(cv.z), bflo(cv.w), bfhi(cv.w)};
#pragma unroll
                for (int e = 0; e < 4; ++e) { acc[ai][bj][m][0][e] *= p0[e] * __builtin_amdgcn_rcpf(fmaxf(n0[e], 1e-20f)); acc[ai][bj][m][1][e] *= p1[e] * __builtin_amdgcn_rcpf(fmaxf(n1[e], 1e-20f)); } } }
    }
    __device__ __forceinline__ void operator()(const acc_t& acc, const pg8::Unit& un, int wr, int wc, int fr, int fq) const {
        unsigned po = (unsigned)((256 * un.pm + 64 * wr + fr) * DM + 256 * un.pn + 32 * wc + 8 * fq);
        const int row0 = 256 * un.pm + 64 * wr + fr, col0 = 256 * un.pn + 32 * wc + 8 * fq;
        u32x4 c[2][2];
#pragma unroll
        for (int bj = 0; bj < 2; ++bj) c[0][bj] = *(const u32x4*)(sgn + po + 128 * bj);
#pragma unroll
        for (int g = 0; g < 8; ++g) { const int ai = g >> 2, m = g & 3, cur = g & 1, nxt = cur ^ 1;
            if (g < 7) { po += (unsigned)((m == 3 ? 80 : 16) * DM); asm volatile("" : "+v"(po));
#pragma unroll
                for (int bj = 0; bj < 2; ++bj) c[nxt][bj] = *(const u32x4*)(sgn + po + 128 * bj); }
#pragma unroll
            for (int bj = 0; bj < 2; ++bj) { const u32x4 cv = c[cur][bj];
                const f32x4 n0 = {bflo(cv.x), bfhi(cv.x), bflo(cv.y), bfhi(cv.y)}, n1 = {bflo(cv.z), bfhi(cv.z), bflo(cv.w), bfhi(cv.w)};
                f32x4 v0, v1;
#pragma unroll
                for (int e = 0; e < 4; ++e) { v0[e] = acc[ai][bj][m][0][e] * fmaxf(n0[e], 1e-20f); v1[e] = acc[ai][bj][m][1][e] * fmaxf(n1[e], 1e-20f); }
                u32x4 w; w.x = pk2(v0[0], v0[1]); w.y = pk2(v0[2], v0[3]); w.z = pk2(v1[0], v1[1]); w.w = pk2(v1[2], v1[3]); *(u32x4*)(mg + t1k_index(row0 + 128 * ai + 16 * m, col0 + 128 * bj)) = w; } }
    }
};

struct EpiG3 {
    static constexpr bool AFTER_DRAIN = false, MID = false;
    const float *x, *mod, *n2g; bf16_t* xnb; float* rowp; bf16_t* xg;
    __device__ __forceinline__ void operator()(const acc_t& acc, const pg8::Unit& un, int wr, int wc, int fr, int fq) const {
        const int b = un.pm >> 5, colb = 256 * un.pn + 32 * wc + 8 * fq;
        const size_t off0 = (size_t)(256 * un.pm + 64 * wr + fr) * DM + colb;
#define XROW(g_) ((size_t)(128 * ((g_) >> 2) + 16 * ((g_) & 3)) * DM)
        f32x4 xp[3][2][2];
#pragma unroll
        for (int g = 0; g < 3; ++g)
#pragma unroll
            for (int bj = 0; bj < 2; ++bj) { xp[g][bj][0] = __builtin_nontemporal_load((const f32x4*)(x + off0 + XROW(g) + 128 * bj)); xp[g][bj][1] = __builtin_nontemporal_load((const f32x4*)(x + off0 + XROW(g) + 128 * bj + 4)); }
        f32x4 g1v[2][2], gm[2][2];
#pragma unroll
        for (int bj = 0; bj < 2; ++bj)
#pragma unroll
            for (int n = 0; n < 2; ++n) { const int col = colb + 128 * bj + 4 * n; g1v[bj][n] = *(const f32x4*)(mod + b * 6144 + 2048 + col);
                gm[bj][n] = *(const f32x4*)(n2g + col) * (*(const f32x4*)(mod + b * 6144 + 4096 + col) + 1.0f); }
#pragma unroll
        for (int g = 0; g < 8; ++g) { const int ai = g >> 2, m = g & 3, row = 256 * un.pm + 128 * ai + 64 * wr + 16 * m + fr; float ss = 0.f;
                f32x4 v[2][2];
#pragma unroll
                for (int bj = 0; bj < 2; ++bj) { v[bj][0] = xp[g % 3][bj][0] + g1v[bj][0] * acc[ai][bj][m][0]; v[bj][1] = xp[g % 3][bj][1] + g1v[bj][1] * acc[ai][bj][m][1]; }
                if (g + 3 < 8) {
#pragma unroll
                    for (int bj = 0; bj < 2; ++bj) { xp[g % 3][bj][0] = __builtin_nontemporal_load((const f32x4*)(x + off0 + XROW(g + 3) + 128 * bj)); xp[g % 3][bj][1] = __builtin_nontemporal_load((const f32x4*)(x + off0 + XROW(g + 3) + 128 * bj + 4)); } }
#pragma unroll
                for (int bj = 0; bj < 2; ++bj) { const size_t off = (size_t)row * DM + colb + 128 * bj; const f32x4 v0 = v[bj][0], v1 = v[bj][1];
                    { u32x4 wn; wn.x = pk2(v0[0], v0[1]); wn.y = pk2(v0[2], v0[3]); wn.z = pk2(v1[0], v1[1]); wn.w = pk2(v1[2], v1[3]); *(u32x4*)(xnb + off) = wn; }
                    ss += (v0[0] * v0[0] + v0[1] * v0[1]) + (v0[2] * v0[2] + v0[3] * v0[3]) + (v1[0] * v1[0] + v1[1] * v1[1]) + (v1[2] * v1[2] + v1[3] * v1[3]);
                    const f32x4 h0 = v0 * gm[bj][0], h1 = v1 * gm[bj][1];
                    u32x4 w; w.x = pk2(h0[0], h0[1]); w.y = pk2(h0[2], h0[3]); w.z = pk2(h1[0], h1[1]); w.w = pk2(h1[2], h1[3]); *(u32x4*)(xg + t1k_index(row, colb + 128 * bj) + (size_t)(row >> 8) * (256 * DM)) = w; }
                ss += __shfl_xor(ss, 16); ss += __shfl_xor(ss, 32);
                if (fq == 0) rowp[(size_t)row * 16 + un.pn * 4 + wc] = ss; }
#undef XROW
    }
};

constexpr int RSTD_OFF = MISC_OFF + 128;
struct EpiG4 {
    static constexpr bool AFTER_DRAIN = false, MID = false;
    const LAS float* bl; bf16_t* h; const LAS float* rs;
    __device__ __forceinline__ void operator()(const acc_t& acc, const pg8::Unit& un, int wr, int wc, int fr, int fq) const {
        const int b = un.pm >> 5, colb = 256 * un.pn + 32 * wc + 8 * fq;
        f32x4 bv[2][2];
#pragma unroll
        for (int bj = 0; bj < 2; ++bj)
#pragma unroll
            for (int n = 0; n < 2; ++n) bv[bj][n] = *(const LAS f32x4*)(bl + un.kind * 256 + 32 * wc + 8 * fq + 128 * bj + 4 * n);
#pragma unroll
        for (int ai = 0; ai < 2; ++ai)
#pragma unroll
            for (int m = 0; m < 4; ++m) { const int rt = 128 * ai + 64 * wr + 16 * m + fr, row = 256 * un.pm + rt; const float rstd = rs[un.kind * 256 + rt];
#pragma unroll
                for (int bj = 0; bj < 2; ++bj) { f32x4 v0 = acc[ai][bj][m][0] * rstd + bv[bj][0], v1 = acc[ai][bj][m][1] * rstd + bv[bj][1];
#pragma unroll
                    for (int e = 0; e < 4; ++e) { const float a0 = fmaxf(v0[e], 0.f), a1 = fmaxf(v1[e], 0.f); v0[e] = a0 * a0; v1[e] = a1 * a1; }
                    u32x4 w; w.x = pk2(v0[0], v0[1]); w.y = pk2(v0[2], v0[3]); w.z = pk2(v1[0], v1[1]); w.w = pk2(v1[2], v1[3]);
                    *(u32x4*)(h + h_index(row, colb + 128 * bj)) = w; } }
    }
};

struct EpiG5 {
    static constexpr bool AFTER_DRAIN = false, MID = false;
    const float* mod; const bf16_t* xnb; float* out;
    __device__ __forceinline__ void operator()(const acc_t& acc, const pg8::Unit& un, int wr, int wc, int fr, int fq) const {
        const int b = un.pm >> 5, colb = 256 * un.pn + 32 * wc + 8 * fq;
        const size_t off0 = (size_t)(256 * un.pm + 64 * wr + fr) * DM + colb;
        u32x4 xp[8][2];
#pragma unroll
        for (int g = 0; g < 8; ++g)
#pragma unroll
            for (int bj = 0; bj < 2; ++bj) xp[g][bj] = __builtin_nontemporal_load((const u32x4*)(xnb + off0 + (size_t)(128 * (g >> 2) + 16 * (g & 3)) * DM + 128 * bj));
        f32x4 g2v[2][2];
#pragma unroll
        for (int bj = 0; bj < 2; ++bj)
#pragma unroll
            for (int n = 0; n < 2; ++n) g2v[bj][n] = *(const f32x4*)(mod + b * 6144 + 5120 + colb + 128 * bj + 4 * n);
#pragma unroll
        for (int ai = 0; ai < 2; ++ai)
#pragma unroll
            for (int m = 0; m < 4; ++m) {
#pragma unroll
                for (int bj = 0; bj < 2; ++bj) { const u32x4 xw = xp[ai * 4 + m][bj];
                    const f32x4 x0 = {bflo(xw.x), bfhi(xw.x), bflo(xw.y), bfhi(xw.y)}, x1 = {bflo(xw.z), bfhi(xw.z), bflo(xw.w), bfhi(xw.w)};
                    const f32x4 v0 = x0 + g2v[bj][0] * acc[ai][bj][m][0], v1 = x1 + g2v[bj][1] * acc[ai][bj][m][1];
                    float* o = out + off0 + (size_t)(128 * ai + 16 * m) * DM + 128 * bj; __builtin_nontemporal_store(v0, (f32x4*)o); __builtin_nontemporal_store(v1, (f32x4*)(o + 4)); } }
    }
};

#define MFMA16(a, b, c) __builtin_amdgcn_mfma_f32_16x16x32_bf16((a), (b), (c), 0, 0, 0)
constexpr int RPB_LD = 56;
#define SB() __builtin_amdgcn_sched_barrier(0)
struct AttnRsrc { __amdgpu_buffer_rsrc_t qr, qp; };
constexpr int ATT_BUF = 65536, ATT_NSTAGE = 16;
__device__ __forceinline__ void attn_dma(const Frame& F, const Ptrs& P, LAS unsigned char* buf, int b, int R0, int h, int kind) {
    if (kind < 3) {
#pragma unroll
        for (int i = 0; i < 6; ++i) { const int p = F.wave * 6 + i, ten = p / 24, row = min(R0 + 3 * kind + (p % 24) / 8, NROWS - 1), pc = p & 7;
            const bf16_t* src = (ten ? P.vt : P.kr) + (size_t)((b * NROWS + row) * NH + h) * 4096 + pc * 512 + F.lane * 8;
            __builtin_amdgcn_global_load_lds((const unsigned*)src, (LAS unsigned*)(buf + p * 1024), 16, 0, 0); }
    } else {
#pragma unroll
        for (int i = 0; i < 8; ++i) { const int p = F.wave * 8 + i;
            const bf16_t* src = ((p >> 5) ? P.vct : P.kc) + (size_t)(b * NH + h) * 16384 + (p & 31) * 512 + F.lane * 8;
            __builtin_amdgcn_global_load_lds((const unsigned*)src, (LAS unsigned*)(buf + p * 1024), 16, 0, 0); }
    }
}
template <int NTHR> __device__ __forceinline__ void stage_rpb(const Frame& F, const Ptrs& P, int t0) {
    LAS float* rl = (LAS float*)(F.lds + RSTD_OFF);
    constexpr int NT = NH * 15 * RPB_LD, NK = (NT + NTHR - 1) / NTHR;
    float tv[NK];
#pragma unroll
    for (int k = 0; k < NK; ++k) { const int i = t0 + NTHR * k, hr = i / RPB_LD, cc = i - hr * RPB_LD - 8; const bool ok = (i < NT) && (cc >= 0) && (cc < 31);
        const float v = P.rpb[ok ? hr * 31 + cc : 0]; tv[k] = ok ? v : 0.f; }
#pragma unroll
    for (int k = 0; k < NK; ++k) { const int i = t0 + NTHR * k; if (i < NT) rl[i] = tv[k]; }
}
__device__ __forceinline__ void attn_phase(const Frame& F, const Ptrs& P, int variant, bool table_staged) {
    AttnRsrc R;
    R.qr = __builtin_amdgcn_make_buffer_rsrc((void*)P.qr, (short)0, MTOK * NAW * 2, 0x00020000); R.qp = __builtin_amdgcn_make_buffer_rsrc((void*)P.qp, (short)0, MTOK * NAW * 2, 0x00020000);
    LAS float* rl = (LAS float*)(F.lds + RSTD_OFF);
    if (!table_staged) { stage_rpb<NWAVES * 64>(F, P, F.tid); __syncthreads(); }
    const int lane = F.lane, qi = lane & 15, fq = lane >> 4, rs = F.wave >> 2, jb = F.wave & 3;
    const float LOG2E = 1.4426950408889634f;
    const f32x4 zero = {0.f, 0.f, 0.f, 0.f};
#define LDF(rs_, so, vo) __builtin_bit_cast(bf16x8, __builtin_amdgcn_raw_buffer_load_b128((rs_), (int)(vo), (int)(so), 2))
    const int item0 = (F.G == 256) ? 4 * (8 * ((int)blockIdx.x % 8) + ((int)blockIdx.x / 8) % 8) + ((int)blockIdx.x / 8) / 8 : F.vcu;
    for (int item = item0; item < NB * NROWS; item += F.G) {
        const int b = item >> 7, rp = (item >> 1) & 63, hh = item & 1, r = 2 * rp;
        if (variant != 2) {
            const int g = F.wave & 3, t0 = (r + hh) * 64 + (F.wave >> 2) * 32 + (lane >> 4) * 8, ch = 16 * g + (lane & 15);
            if (g == 0) pool_seg8<2>(P, b, t0, ch); else if (g == 1) pool_seg8<4>(P, b, t0, ch); else if (g == 2) pool_seg8<8>(P, b, t0, ch); else pool_seg8<16>(P, b, t0, ch);
        }
        if (variant == 1) continue;
        const int R0 = min(max(r - 4, 0), NROWS - 8), rq = r + rs, w0 = min(max(rq - 4, 0), NROWS - 8) - R0;
        const int c = 16 * jb + qi, kc0 = min(max(16 * jb - 8, 0), 32), c0 = min(max(c - 8, 0), GW - 16), kq0 = kc0 + 8 * fq - c0;
        const unsigned qoff = (unsigned)(qi * NAW + 8 * fq) * 2u, ooff = (unsigned)(qi * DM + 4 * fq) * 2u;
        const int eq0 = (kc0 >> 3) + (qi >> 2);
        const unsigned kl = (unsigned)((fq * 4 + (eq0 >> 2)) * 256 + ((qi & 3) * 4 + (eq0 & 3)) * 16);
        const unsigned vl = (unsigned)(((kc0 >> 3) + fq) * 1024 + qi * 16);
        const unsigned cl = (unsigned)lane * 16u;
        bf16x8 qr0, qr1, qp0, qp1; float m = -INFINITY, l = 0.f; f32x4 o[4] = {zero, zero, zero, zero};
        { const unsigned qS = (unsigned)(((b * SEQ + rq * 64 + 16 * jb) * NAW + (4 * hh) * 64) * 2);
          qr0 = LDF(R.qr, qS, qoff); qr1 = LDF(R.qr, qS + 64u, qoff); qp0 = LDF(R.qp, qS, qoff); qp1 = LDF(R.qp, qS + 64u, qoff); }
        attn_dma(F, P, F.lds, b, R0, 4 * hh, 0);
#define LB(p) (*(const LAS bf16x8*)(p))
#define STAGE_SOFTMAX(NC) do { \
            float cm_ = -INFINITY; \
            _Pragma("unroll") for (int c_ = 0; c_ < NC; ++c_) _Pragma("unroll") for (int e_ = 0; e_ < 8; ++e_) cm_ = fmaxf(cm_, sc[c_][e_]); \
            cm_ = max_x16_x32(cm_); \
            const float mn_ = fmaxf(m, cm_), al_ = __builtin_amdgcn_exp2f((m - mn_) * LOG2E), ml_ = mn_ * LOG2E; m = mn_; \
            float ps_ = 0.f; \
            _Pragma("unroll") for (int c_ = 0; c_ < NC; ++c_) { \
                _Pragma("unroll") for (int e_ = 0; e_ < 8; ++e_) { sc[c_][e_] = __builtin_amdgcn_exp2f(sc[c_][e_] * LOG2E - ml_); ps_ += sc[c_][e_]; } \
                u32x4 pw_; pw_.x = pk2(sc[c_][0], sc[c_][1]); pw_.y = pk2(sc[c_][2], sc[c_][3]); pw_.z = pk2(sc[c_][4], sc[c_][5]); pw_.w = pk2(sc[c_][6], sc[c_][7]); pa[c_] = __builtin_bit_cast(bf16x8, pw_); } \
            l = l * al_ + ps_; \
            _Pragma("unroll") for (int db_ = 0; db_ < 4; ++db_) o[db_] = o[db_] * al_; } while (0)
        asm volatile(".p2align 8" ::: "memory");
        u32x2 pend[4]; int pend_h = -1;
        for (int t = 0; t < ATT_NSTAGE; ++t) {
            const int hi = t >> 2, kind = t & 3, h = 4 * hh + hi;
            LAS unsigned char* buf = F.lds + (t & 1) * ATT_BUF;
            __syncthreads();
            bf16x8 nq0, nq1, np0, np1;
            if (kind == 3 && hi < 3) { const unsigned qS = (unsigned)(((b * SEQ + rq * 64 + 16 * jb) * NAW + (h + 1) * 64) * 2);
                nq0 = LDF(R.qr, qS, qoff); nq1 = LDF(R.qr, qS + 64u, qoff); np0 = LDF(R.qp, qS, qoff); np1 = LDF(R.qp, qS + 64u, qoff); }
            if (t + 1 < ATT_NSTAGE) attn_dma(F, P, F.lds + ((t + 1) & 1) * ATT_BUF, b, R0, 4 * hh + ((t + 1) >> 2), (t + 1) & 3);
            if (pend_h >= 0) { char* oU = (char*)((variant >= 5 ? P.xn : P.dn) + ((size_t)b * SEQ + rq * 64 + 16 * jb) * DM + 512 + pend_h * 64);
#pragma unroll
                for (int db = 0; db < 4; ++db) *(u32x2*)(oU + 32 * db + ooff) = pend[db];
                pend_h = -1; }
            if (kind < 3) {
                float sc[3][8]; bf16x8 pa[3];
                {
                    bf16x8 ka[4], kn[4];
                    { const LAS unsigned char* kb = buf + kl; ka[0] = LB(kb); ka[1] = LB(kb + 4096); ka[2] = LB(kb + 512); ka[3] = LB(kb + 4096 + 512); }
#pragma unroll
                    for (int j = 0; j < 3; ++j) { const int wr = 3 * kind + j - w0;
                        if (j < 2) { const LAS unsigned char* kb = buf + (j + 1) * 8192 + kl; kn[0] = LB(kb); kn[1] = LB(kb + 4096); kn[2] = LB(kb + 512); kn[3] = LB(kb + 4096 + 512); }
                        if (wr >= 0 && wr < 8) {
                            const LAS float* bp = rl + h * 15 * RPB_LD + (R0 + w0 - rq + 7 + wr) * RPB_LD + (kc0 + 8 * fq - c + 23);
                            float bs[8];
#pragma unroll
                            for (int e = 0; e < 8; ++e) bs[e] = bp[e];
                            SB();
                            f32x4 s0 = MFMA16(ka[0], qr0, zero); f32x4 s1 = MFMA16(ka[2], qr0, zero); s0 = MFMA16(ka[1], qr1, s0); s1 = MFMA16(ka[3], qr1, s1);
#pragma unroll
                            for (int e = 0; e < 8; ++e) { const bool valid = (unsigned)(kq0 + e) < 16u; sc[j][e] = valid ? (e < 4 ? s0[e & 3] : s1[e & 3]) + bs[e] : -INFINITY; }
                        } else {
#pragma unroll
                            for (int e = 0; e < 8; ++e) sc[j][e] = -INFINITY; }
                        SB();
                        if (j < 2) { ka[0] = kn[0]; ka[1] = kn[1]; ka[2] = kn[2]; ka[3] = kn[3]; } }
                }
                STAGE_SOFTMAX(3);
                {
                    bf16x8 va[4], vn[4];
                    { const LAS unsigned char* vb = buf + 24576 + vl; va[0] = LB(vb); va[1] = LB(vb + 256); va[2] = LB(vb + 512); va[3] = LB(vb + 768); }
#pragma unroll
                    for (int j = 0; j < 3; ++j) { const int wr = 3 * kind + j - w0;
                        if (j < 2) { const LAS unsigned char* vb = buf + 24576 + (j + 1) * 8192 + vl; vn[0] = LB(vb); vn[1] = LB(vb + 256); vn[2] = LB(vb + 512); vn[3] = LB(vb + 768); }
                        SB();
                        if (wr >= 0 && wr < 8) { o[0] = MFMA16(va[0], pa[j], o[0]); o[1] = MFMA16(va[1], pa[j], o[1]); o[2] = MFMA16(va[2], pa[j], o[2]); o[3] = MFMA16(va[3], pa[j], o[3]); }
                        SB();
                        if (j < 2) { va[0] = vn[0]; va[1] = vn[1]; va[2] = vn[2]; va[3] = vn[3]; } }
                }
            } else {
                float sc[8][8]; bf16x8 pa[8];
                bf16x8 ka[4], kn[4];
                { const LAS unsigned char* kb = buf + cl; ka[0] = LB(kb); ka[1] = LB(kb + 1024); ka[2] = LB(kb + 2048); ka[3] = LB(kb + 3072); }
#pragma unroll
                for (int g = 0; g < 8; ++g) {
                    if (g < 7) { const LAS unsigned char* kb = buf + (g + 1) * 4096 + cl; kn[0] = LB(kb); kn[1] = LB(kb + 1024); kn[2] = LB(kb + 2048); kn[3] = LB(kb + 3072); }
                    SB();
                    f32x4 s0 = MFMA16(ka[0], qp0, zero); f32x4 s1 = MFMA16(ka[2], qp0, zero); s0 = MFMA16(ka[1], qp1, s0); s1 = MFMA16(ka[3], qp1, s1);
                    SB();
                    if (g < 7) { ka[0] = kn[0]; ka[1] = kn[1]; ka[2] = kn[2]; ka[3] = kn[3]; }
#pragma unroll
                    for (int e = 0; e < 8; ++e) sc[g][e] = (e < 4 ? s0[e & 3] : s1[e & 3]); }
                STAGE_SOFTMAX(8);
                {   bf16x8 va[4], vn[4];
                    { const LAS unsigned char* vb = buf + 32768 + cl; va[0] = LB(vb); va[1] = LB(vb + 1024); va[2] = LB(vb + 2048); va[3] = LB(vb + 3072); }
#pragma unroll
                    for (int g = 0; g < 8; ++g) {
                        if (g < 7) { const LAS unsigned char* vb = buf + 32768 + (g + 1) * 4096 + cl; vn[0] = LB(vb); vn[1] = LB(vb + 1024); vn[2] = LB(vb + 2048); vn[3] = LB(vb + 3072); }
                        SB();
                        o[0] = MFMA16(va[0], pa[g], o[0]); o[1] = MFMA16(va[1], pa[g], o[1]); o[2] = MFMA16(va[2], pa[g], o[2]); o[3] = MFMA16(va[3], pa[g], o[3]);
                        SB();
                        if (g < 7) { va[0] = vn[0]; va[1] = vn[1]; va[2] = vn[2]; va[3] = vn[3]; } }
                }
                const float lt = sum_x16_x32(l);
                const float il = 1.0f / lt;
#pragma unroll
                for (int db = 0; db < 4; ++db) { const f32x4 ov = o[db] * il; pend[db].x = pk2(ov[0], ov[1]); pend[db].y = pk2(ov[2], ov[3]); o[db] = zero; }
                pend_h = h;
                m = -INFINITY; l = 0.f;
                if (hi < 3) { qr0 = nq0; qr1 = nq1; qp0 = np0; qp1 = np1; }
            }
        }
        if (pend_h >= 0) { char* oU = (char*)((variant >= 5 ? P.xn : P.dn) + ((size_t)b * SEQ + rq * 64 + 16 * jb) * DM + 512 + pend_h * 64);
#pragma unroll
            for (int db = 0; db < 4; ++db) *(u32x2*)(oU + 32 * db + ooff) = pend[db]; }
        __syncthreads();
#undef STAGE_SOFTMAX
#undef LB
    }
#undef LDF
}

__global__ void __launch_bounds__(NWAVES * 64, 2) mk_fwd(Args args) {
    extern __shared__ __attribute__((aligned(16))) unsigned char lds_raw[];
    Frame F; F.lds = (LAS unsigned char*)lds_raw;
    volatile LAS unsigned* MISC = (volatile LAS unsigned*)(F.lds + MISC_OFF);
    F.tid = threadIdx.x; F.lane = F.tid & 63; F.wave = __builtin_amdgcn_readfirstlane(F.tid >> 6);
    F.G = gridDim.x; { const int bx = blockIdx.x; F.vcu = (F.G % 8 == 0) ? (bx % 8) * (F.G / 8) + bx / 8 : bx; }
    const Ptrs P = make_ptrs(args);
    for (int u = F.tid; u < (LDS_BYTES - LDSCTL_OFF) / 4; u += NWAVES * 64) ((LAS unsigned*)(F.lds + LDSCTL_OFF))[u] = 0u;
    __syncthreads();
    XcdBarrier bar; bar.bar = (unsigned*)(P.ws + WS_CTL) + CW_BAR + args.li * XCD_BAR_WORDS; bar.x = 0; bar.st = nullptr;
#if ONE_LAUNCH
    bar = xcd_barrier_post((unsigned*)(P.ws + WS_CTL) + CW_BAR + args.li * XCD_BAR_WORDS, MISC + 8);
#define GRID_BAR() xcd_barrier(bar)
#define SHADOW_BAR(k, work) do { if (BOTH(k)) xcd_barrier_shadow(bar, [&]() { work; }); else { __syncthreads(); if (threadIdx.x >= 64) { work; } __syncthreads(); } } while (0)
#else
#define GRID_BAR() do { } while (0)
#define SHADOW_BAR(k, work) do { __syncthreads(); if (threadIdx.x >= 64) { work; } __syncthreads(); } while (0)
#endif
    const bool use_grp = ONE_LAUNCH && F.G == 256;
    GroupBarrier gb; { const int c = blockIdx.x, g = 8 * (c % 8) + (c / 8) % 8; gb.cnt = (unsigned*)(P.ws + WS_CTL) + CW_GRP + args.li * 4096 + 64 * g; gb.gen = 0u; gb.same_xcd = false; }
    if (use_grp && F.tid == 0) (void)__hip_atomic_fetch_add((unsigned long long*)(gb.cnt + 2), 1ull << (4u * xb_xcc_id()), __ATOMIC_RELAXED, __HIP_MEMORY_SCOPE_AGENT);
#define PANEL_BAR(k, ...) do { if (BOTH(k)) { if (use_grp) group_barrier(gb, bar.bar, ##__VA_ARGS__); else GRID_BAR(); } } while (0)
    unsigned* att_done = (unsigned*)(P.ws + WS_CTL) + CW_PROG + args.li * 256; unsigned* g2_done = att_done + 64;
    const int lo = args.ph_lo, hi = args.ph_hi;
#ifndef PH_MASK
#define PH_MASK 0xFF
#endif
#define IN(k) (((PH_MASK >> (k)) & 1) && lo <= (k) && (k) < hi)
#define BOTH(k) (IN(k) && IN((k) + 1))
    if (IN(0)) { phase0(F, P, args.pad);   }
    if (IN(1)) {
        phase1(F, P);
        if (F.G > 32 && F.vcu < 32) {
            SchedCtx S{(const char*)P.xn, (const char*)P.wtin, F.vcu};
            EpiCtx E{P.zc};
            pg8::gemm_phase<EpiCtx, SchedCtx, true, true>(F.lds, pg8::Gemm{DM, 256}, S, E);
        }
        SHADOW_BAR(1, fold_items(F, P));
    }
    if (IN(2)) {
        const f32x4 rt0 = ((const f32x4*)P.tab)[F.tid], rt1 = ((const f32x4*)P.tab)[F.tid + NWAVES * 64];
        if (F.G <= 32) ctx_kv(F, P); else ctx_finalize(F, P);
        SchedG1 S{(const char*)P.xn, (const char*)P.wtin, F.G, (int)blockIdx.x};
        { LAS f32x4* tl = (LAS f32x4*)(F.lds + RSTD_OFF); tl[F.tid] = rt0; tl[F.tid + NWAVES * 64] = rt1; }
        EpiG1 E{P.u, P.qr, P.qp, P.kr, P.vt, P.sgp, P.sgn, P.qg, P.kg, (const LAS f32x2*)(F.lds + RSTD_OFF), args.pad};
        pg8::gemm_phase<EpiG1, SchedG1, true, true>(F.lds, pg8::Gemm{DM, DM}, S, E);
        bias2_items(F, P, F.vcu * NWAVES + F.wave, F.G * NWAVES);
        SHADOW_BAR(2, stage_rpb<NWAVES * 64 - 64>(F, P, (int)threadIdx.x - 64));
    }
    if (IN(3)) {
        attn_phase(F, P, args.pad, IN(2));
        PANEL_BAR(3, att_done);
    }
    if (IN(4)) {
        SchedStd S{(const char*)P.dn, (const char*)P.wtbr, MTOK / 256, DM / 256, DM * 2, F.G, (int)blockIdx.x};
        EpiG2 E{P.sgp, P.sgn, P.mg};
        pg8::gemm_phase<EpiG2, SchedStd, true, true>(F.lds, pg8::Gemm{DM, DM}, S, E);
        PANEL_BAR(4, g2_done, BOTH(3) ? att_done : nullptr, (unsigned)F.G);
    }
    if (IN(5)) {
        SchedStd S{(const char*)P.mg, (const char*)P.wtout, MTOK / 256, DM / 256, DM * 2, F.G, (int)blockIdx.x};
        EpiG3 E{P.x, P.mod, P.n2g, P.xnb, P.rowp, P.xg};
        pg8::gemm_phase<EpiG3, SchedStd, true, true, true>(F.lds, pg8::Gemm{DM, DM}, S, E);
        PANEL_BAR(5, nullptr, BOTH(4) ? g2_done : nullptr, (unsigned)F.G);
    }
    if (IN(6)) {
        SchedG4 S{(const char*)P.xg, (const char*)P.wt1, F.G, (int)blockIdx.x};
        LAS float* rs = (LAS float*)(F.lds + RSTD_OFF); LAS float* bls = rs + 12 * 256;
        { pg8::Unit un;
          f32x4 rv[2][4]; bool ok[2]; float bq[2];
#pragma unroll
          for (int j = 0; j < 2; ++j) { const int i = (F.tid >> 8) + 2 * j; ok[j] = S.next(i, un); const float* rp = P.rowp + (size_t)(256 * (ok[j] ? un.pm : 0) + (F.tid & 255)) * 16;
#pragma unroll
              for (int q = 0; q < 4; ++q) rv[j][q] = *(const f32x4*)(rp + 4 * q);
              bq[j] = P.bias2[(ok[j] ? (un.pm >> 5) * FF + 256 * un.pn : 0) + (F.tid & 255)]; }
#pragma unroll
          for (int j = 0; j < 2; ++j) if (ok[j]) { float sq = 0.f;
#pragma unroll
              for (int q = 0; q < 4; ++q) sq += (rv[j][q].x + rv[j][q].y) + (rv[j][q].z + rv[j][q].w);
              rs[((F.tid >> 8) + 2 * j) * 256 + (F.tid & 255)] = rsqrtf(sq * (1.0f / DM) + EPS); bls[((F.tid >> 8) + 2 * j) * 256 + (F.tid & 255)] = bq[j]; }
          for (int i = 4; i < 12 && S.next(i, un); ++i)
              for (int rt = F.tid; rt < 256; rt += NWAVES * 64) { const float* rp = P.rowp + (size_t)(256 * un.pm + rt) * 16; float sq = 0.f;
#pragma unroll
                  for (int q = 0; q < 4; ++q) { const f32x4 v = *(const f32x4*)(rp + 4 * q); sq += (v.x + v.y) + (v.z + v.w); }
                  rs[i * 256 + rt] = rsqrtf(sq * (1.0f / DM) + EPS); bls[i * 256 + rt] = P.bias2[(un.pm >> 5) * FF + 256 * un.pn + rt]; }
          __syncthreads(); }
        EpiG4 E{bls, P.h, rs};
        pg8::gemm_phase<EpiG4, SchedG4, true, true, true>(F.lds, pg8::Gemm{DM, DM}, S, E);
        PANEL_BAR(6);
    }
    if (IN(7)) {
        SchedStd S{(const char*)P.h, (const char*)P.wt2, MTOK / 256, DM / 256, FF * 2, F.G, (int)blockIdx.x};
        EpiG5 E{P.mod, P.xnb, P.out};
        pg8::gemm_phase<EpiG5, SchedStd, true, true, true>(F.lds, pg8::Gemm{FF, FF}, S, E);
    }
#undef IN
#undef BOTH
}

extern "C" void kernel_launch(void* const* d_in, const int* in_sizes, int n_in, void* d_out, int out_size, void* d_ws, size_t ws_size, hipStream_t stream) {
    static int grid = 0;
    if (grid == 0) {
        if (n_in != 19 || in_sizes[0] != MTOK * DM || out_size != MTOK * DM || ws_size < WS_END) { fprintf(stderr, "kernel_launch: unexpected problem shape / workspace (%d inputs, ws %zu)\n", n_in, ws_size); grid = -1; return; }
        int dev = 0, cus = 0, per_cu = 0;
        if (hipGetDevice(&dev) != hipSuccess || hipDeviceGetAttribute(&cus, hipDeviceAttributeMultiprocessorCount, dev) != hipSuccess) { grid = -1; return; }
        if (hipFuncSetAttribute((const void*)mk_fwd, hipFuncAttributeMaxDynamicSharedMemorySize, LDS_BYTES) != hipSuccess) { fprintf(stderr, "kernel_launch: hipFuncSetAttribute failed\n"); grid = -1; return; }
        if (hipOccupancyMaxActiveBlocksPerMultiprocessor(&per_cu, (const void*)mk_fwd, NWAVES * 64, LDS_BYTES) != hipSuccess || per_cu < 1) { fprintf(stderr, "kernel_launch: occupancy query reports %d workgroups per CU\n", per_cu); (void)hipGetLastError(); grid = -1; return; }
        grid = cus;
    }
    if (grid < 0) return;
    (void)hipMemsetAsync((char*)d_ws + WS_CTL, 0, CTL_ZERO_BYTES, stream);
    Args a{};
    for (int i = 0; i < 19; ++i) a.in[i] = (const float*)d_in[i];
    a.out = (float*)d_out; a.ws = (unsigned char*)d_ws;
#if ONE_LAUNCH
#if DUP_PHASE >= 0
#if DUP_MODE == 3
    a.ph_lo = 0; a.ph_hi = DUP_PHASE + 1; a.li = 1; a.pad = DUP_VARIANT;
    hipLaunchKernelGGL(mk_fwd, dim3(grid), dim3(NWAVES * 64), LDS_BYTES, stream, a);
    a.ph_lo = 0; a.ph_hi = NPH; a.li = 0; a.pad = 0;
    hipLaunchKernelGGL(mk_fwd, dim3(grid), dim3(NWAVES * 64), LDS_BYTES, stream, a);
    return;
#elif DUP_MODE == 2
    a.ph_lo = 0; a.ph_hi = NPH; a.li = 0;
#else
    a.ph_lo = 0; a.ph_hi = DUP_PHASE + 1; a.li = 0;
#endif
    hipLaunchKernelGGL(mk_fwd, dim3(grid), dim3(NWAVES * 64), LDS_BYTES, stream, a);
    a.ph_lo = DUP_PHASE; a.ph_hi = NPH; a.li = 1; a.pad = DUP_VARIANT;
    hipLaunchKernelGGL(mk_fwd, dim3(grid), dim3(NWAVES * 64), LDS_BYTES, stream, a);
#else
    a.ph_lo = 0; a.ph_hi = NPH;
    hipLaunchKernelGGL(mk_fwd, dim3(grid), dim3(NWAVES * 64), LDS_BYTES, stream, a);
#endif
#else
    for (int ph = 0; ph < NPH; ++ph) {
        a.ph_lo = ph; a.ph_hi = ph + 1;
        if ((NAIVE_MASK >> ph) & 1) {
            switch (ph) {
                case 2: hipLaunchKernelGGL(naive_g1, dim3(1024), dim3(512), 0, stream, a); break;
                case 3: hipLaunchKernelGGL(naive_attn, dim3(2048), dim3(256), 0, stream, a); break;
                case 4: hipLaunchKernelGGL(naive_g2, dim3(1024), dim3(512), 0, stream, a); break;
                case 5: hipLaunchKernelGGL(naive_g3, dim3(1024), dim3(512), 0, stream, a); break;
                case 6: hipLaunchKernelGGL(naive_g4, dim3(1024), dim3(512), 0, stream, a); break;
                case 7: hipLaunchKernelGGL(naive_g5, dim3(1024), dim3(512), 0, stream, a); break;
                default: break;
            }
        } else {
            hipLaunchKernelGGL(mk_fwd, dim3(grid), dim3(NWAVES * 64), LDS_BYTES, stream, a);
            if (ph == DUP_PHASE) hipLaunchKernelGGL(mk_fwd, dim3(grid), dim3(NWAVES * 64), LDS_BYTES, stream, a);
        }
    }
#endif
}
```
